# Optimizing an MI355X kernel written in HIP

```python
import math
import jax, jax.numpy as jnp
from jax import lax
import numpy as np

D_MODEL = 1024
BATCH = 2
SEQ = 8192
DEPTH = 1

N_DIFF_HEADS = 8
DIFF_HEAD_DIM = 64
DIFF_V_DIM = 2 * DIFF_HEAD_DIM
ATTN_WIDTH = N_DIFF_HEADS * 2 * DIFF_HEAD_DIM
CONV_WIDTH = 1024
CONV_K = 3
SPLIT_SIZES = (ATTN_WIDTH, ATTN_WIDTH, ATTN_WIDTH, CONV_WIDTH, CONV_WIDTH, CONV_WIDTH, D_MODEL, D_MODEL)
SPLIT_POINTS = tuple(int(v) for v in np.cumsum(SPLIT_SIZES)[:-1])
IN_WIDTH = int(sum(SPLIT_SIZES))
N_EXPERTS = 32
TOP_K = 4
D_FF = 1024
SWIGLU_LIMIT = 7.0
SWIGLU_ALPHA = 1.702
ROPE_THETA = 10000.0
RMS_EPS = 1e-6
SUBLN_EPS = 1e-5
Q_BLOCK = 128
MOE_BLOCK = 128

kernel_name = "hybrid_diffattn_shortconv_moe_encoder_block"


def rmsnorm(x, g, eps=RMS_EPS):
    xf = x.astype(jnp.float32)
    y = xf * lax.rsqrt(jnp.mean(xf * xf, axis=-1, keepdims=True) + eps)
    return (y * g.astype(jnp.float32)).astype(x.dtype)


def rope(t, seq_len):
    dh = t.shape[-1]
    inv_freq = ROPE_THETA ** (-jnp.arange(0, dh, 2, dtype=jnp.float32) / dh)
    pos = jnp.arange(seq_len, dtype=jnp.float32)
    ang = pos[:, None] * inv_freq[None, :]
    emb = jnp.concatenate([ang, ang], axis=-1)[None, :, None, None, :]
    cos, sin = jnp.cos(emb), jnp.sin(emb)
    tf = t.astype(jnp.float32)
    t1, t2 = jnp.split(tf, 2, axis=-1)
    rot = jnp.concatenate([-t2, t1], axis=-1)
    return (tf * cos + rot * sin).astype(t.dtype)


def diff_attention(q, k, v, lam):
    b, s, h, _, dh = q.shape
    nq = s // Q_BLOCK
    qb = q.reshape(b, nq, Q_BLOCK, h, 2, dh).transpose(1, 0, 2, 3, 4, 5)
    scale = 1.0 / math.sqrt(dh)

    def one_block(q_blk):
        sc = jnp.einsum('bqhcd,bkhcd->bhcqk', q_blk, k).astype(jnp.float32) * scale
        p = jax.nn.softmax(sc, axis=-1)
        a = p[:, :, 0] - lam * p[:, :, 1]
        return jnp.einsum('bhqk,bkhd->bqhd', a.astype(v.dtype), v)

    o = lax.map(one_block, qb)
    return o.transpose(1, 0, 2, 3, 4).reshape(b, s, h, v.shape[-1])


def short_conv(z, w):
    return lax.conv_general_dilated(
        z, w[:, None, :].astype(z.dtype), window_strides=(1,),
        padding=[(CONV_K // 2, CONV_K // 2)],
        dimension_numbers=('NWC', 'WIO', 'NWC'),
        feature_group_count=z.shape[-1])


def moe(h, w_router, b_router, w_gate_up, b_gate_up, w_down, b_down):
    n, d = h.shape
    logits = h.astype(jnp.float32) @ w_router.astype(jnp.float32) + b_router.astype(jnp.float32)
    top_vals, top_idx = lax.top_k(logits, TOP_K)
    top_w = jax.nn.softmax(top_vals, axis=-1)
    nk = n * TOP_K
    flat_e = top_idx.reshape(-1)
    flat_tok = jnp.broadcast_to(jnp.arange(n, dtype=jnp.int32)[:, None], (n, TOP_K)).reshape(-1)
    flat_w = top_w.reshape(-1)
    order = jnp.argsort(flat_e)
    sorted_e = flat_e[order]
    counts = jnp.bincount(flat_e, length=N_EXPERTS)
    padded = ((counts + MOE_BLOCK - 1) // MOE_BLOCK) * MOE_BLOCK
    ends_pad = jnp.cumsum(padded)
    start_pad = ends_pad - padded
    start = jnp.cumsum(counts) - counts
    dest = start_pad[sorted_e] + (jnp.arange(nk) - start[sorted_e])
    p_rows = nk + N_EXPERTS * MOE_BLOCK
    n_blocks = p_rows // MOE_BLOCK
    row_tok = jnp.full((p_rows,), n, dtype=jnp.int32).at[dest].set(flat_tok[order])
    row_w = jnp.zeros((p_rows,), jnp.float32).at[dest].set(flat_w[order])
    block_e = jnp.clip(jnp.searchsorted(ends_pad, jnp.arange(n_blocks) * MOE_BLOCK, side='right'),
                       0, N_EXPERTS - 1)
    h_pad = jnp.concatenate([h, jnp.zeros((1, d), h.dtype)], axis=0)
    xs = h_pad[row_tok].reshape(n_blocks, MOE_BLOCK, d)

    def expert_block(args):
        xb, e = args
        gu = xb @ w_gate_up[e] + b_gate_up[e]
        gate = jnp.minimum(gu[..., ::2], SWIGLU_LIMIT)
        up = jnp.clip(gu[..., 1::2], -SWIGLU_LIMIT, SWIGLU_LIMIT)
        glu = gate * jax.nn.sigmoid(gate * SWIGLU_ALPHA)
        return ((up + 1.0) * glu) @ w_down[e] + b_down[e]

    ys = lax.map(expert_block, (xs, block_e)).reshape(p_rows, d)
    ys = (ys.astype(jnp.float32) * row_w[:, None]).astype(h.dtype)
    out = jnp.zeros((n + 1, d), h.dtype).at[row_tok].add(ys)
    return out[:n]


def setup_inputs(seed: int = 0) -> dict:
    key = jax.random.key(seed)
    ks = jax.random.split(key, 32)
    f32 = jnp.float32
    L, D, H, dh = DEPTH, D_MODEL, N_DIFF_HEADS, DIFF_HEAD_DIM
    nrm = lambda k, shape, s: jax.random.normal(k, shape, f32) * s
    return {
        "x": nrm(ks[0], (BATCH, SEQ, D), 1.0),
        "c": nrm(ks[1], (BATCH, D), 1.0),
        "w_ada": nrm(ks[2], (L, D, 6 * D), 0.5 * D ** -0.5),
        "b_ada": nrm(ks[3], (L, 6 * D), 0.01),
        "norm1_w": 1.0 + nrm(ks[4], (L, D), 0.02),
        "w_in": nrm(ks[5], (L, D, IN_WIDTH), D ** -0.5),
        "q_norm_w": 1.0 + nrm(ks[6], (L, dh), 0.02),
        "k_norm_w": 1.0 + nrm(ks[7], (L, dh), 0.02),
        "lambda_q1": nrm(ks[8], (L, dh), 0.1),
        "lambda_k1": nrm(ks[9], (L, dh), 0.1),
        "lambda_q2": nrm(ks[10], (L, dh), 0.1),
        "lambda_k2": nrm(ks[11], (L, dh), 0.1),
        "subln_w": 1.0 + nrm(ks[12], (L, DIFF_V_DIM), 0.02),
        "w_attn_o": nrm(ks[13], (L, H * DIFF_V_DIM, D), (H * DIFF_V_DIM) ** -0.5),
        "conv_w": nrm(ks[14], (L, CONV_K, CONV_WIDTH), CONV_K ** -0.5),
        "w_conv_o": nrm(ks[15], (L, CONV_WIDTH, D), CONV_WIDTH ** -0.5),
        "w_out": nrm(ks[16], (L, D, D), D ** -0.5),
        "norm2_w": 1.0 + nrm(ks[17], (L, D), 0.02),
        "w_router": nrm(ks[18], (L, D, N_EXPERTS), D ** -0.5),
        "b_router": nrm(ks[19], (L, N_EXPERTS), 0.01),
        "w_gate_up": nrm(ks[20], (L, N_EXPERTS, D, 2 * D_FF), D ** -0.5),
        "b_gate_up": nrm(ks[21], (L, N_EXPERTS, 2 * D_FF), 0.01),
        "w_down": nrm(ks[22], (L, N_EXPERTS, D_FF, D), D_FF ** -0.5),
        "b_down": nrm(ks[23], (L, N_EXPERTS, D), 0.01),
    }


def reference(x, c, w_ada, b_ada, norm1_w, w_in, q_norm_w, k_norm_w, lambda_q1, lambda_k1,
              lambda_q2, lambda_k2, subln_w, w_attn_o, conv_w, w_conv_o, w_out, norm2_w,
              w_router, b_router, w_gate_up, b_gate_up, w_down, b_down):
    b, s, d = x.shape
    H, dh = N_DIFF_HEADS, DIFF_HEAD_DIM
    for l in range(DEPTH):
        lambda_init = 0.8 - 0.6 * math.exp(-0.3 * l)
        mod = jax.nn.silu(c) @ w_ada[l] + b_ada[l]
        sh1, sc1, g1, sh2, sc2, g2 = jnp.split(mod[:, None, :], 6, axis=-1)

        h = rmsnorm(x, norm1_w[l]) * (1.0 + sc1) + sh1
        proj = h @ w_in[l]
        q, k, v, cb, cc, cx, ga, gc = jnp.split(proj, SPLIT_POINTS, axis=-1)

        q = rope(rmsnorm(q.reshape(b, s, H, 2, dh), q_norm_w[l]), s)
        k = rope(rmsnorm(k.reshape(b, s, H, 2, dh), k_norm_w[l]), s)
        v = v.reshape(b, s, H, DIFF_V_DIM)
        lam = (jnp.exp(jnp.sum(lambda_q1[l].astype(jnp.float32) * lambda_k1[l].astype(jnp.float32)))
               - jnp.exp(jnp.sum(lambda_q2[l].astype(jnp.float32) * lambda_k2[l].astype(jnp.float32)))
               + lambda_init)
        o = diff_attention(q, k, v, lam)
        o = rmsnorm(o, subln_w[l], SUBLN_EPS) * (1.0 - lambda_init)
        y_attn = o.reshape(b, s, H * DIFF_V_DIM) @ w_attn_o[l]

        y_conv = (cb * short_conv(cc * cx, conv_w[l])) @ w_conv_o[l]

        m = jax.nn.sigmoid(ga) * y_attn + jax.nn.sigmoid(gc) * y_conv
        x = x + g1 * (m @ w_out[l])

        h2 = rmsnorm(x, norm2_w[l]) * (1.0 + sc2) + sh2
        y_moe = moe(h2.reshape(b * s, d), w_router[l], b_router[l], w_gate_up[l], b_gate_up[l],
                    w_down[l], b_down[l]).reshape(b, s, d)
        x = x + g2 * y_moe
    return x
```

```cpp
#include <hip/hip_runtime.h>
#include <hip/hip_bf16.h>
#include <cstdio>
#include <cstdint>
#include <cmath>

#ifndef PROBE_REP_MOE
#define PROBE_REP_MOE 1
#endif
#ifndef PROBE_REP_G1
#define PROBE_REP_G1 1
#endif
#ifndef MK_PER_PHASE
#define MK_PER_PHASE 0
#endif

#define LAS __attribute__((address_space(3)))
#define GAS __attribute__((address_space(1)))
typedef unsigned short bf16_t;
typedef short bf16x8 __attribute__((ext_vector_type(8)));
typedef short s16x4 __attribute__((ext_vector_type(4)));
typedef float f32x4 __attribute__((ext_vector_type(4)));
typedef float f32x2 __attribute__((ext_vector_type(2)));
typedef float f32x16 __attribute__((ext_vector_type(16)));
typedef unsigned u32x4 __attribute__((ext_vector_type(4)));
typedef unsigned u32x2 __attribute__((ext_vector_type(2)));
typedef GAS unsigned gu32;
typedef int v4i __attribute__((ext_vector_type(4)));
typedef int v8i __attribute__((ext_vector_type(8)));
__device__ __forceinline__ unsigned cvt4_fp8(float a, float b, float c, float d) {
    a = fminf(fmaxf(a, -448.f), 448.f); b = fminf(fmaxf(b, -448.f), 448.f); c = fminf(fmaxf(c, -448.f), 448.f); d = fminf(fmaxf(d, -448.f), 448.f);
    int w = __builtin_amdgcn_cvt_pk_fp8_f32(a, b, 0, false); w = __builtin_amdgcn_cvt_pk_fp8_f32(c, d, w, true); return (unsigned)w; }
constexpr int FP8_SCALE_Q = 0x7C7C7C7C;
constexpr int FP8_SCALE_ONE = 0x7F7F7F7F, FP8_SCALE_W = 0x7A7A7A7A;
constexpr float FP8_W_MUL = 32.0f;

constexpr int BATCH = 2, SEQ = 8192, D = 1024, M = BATCH * SEQ;
constexpr int NH = 8, DH = 64, INW = 8192;
constexpr int NE = 32, TOPK = 4, DFF = 1024;
constexpr int C_Q = 0, C_K = 1024, C_V = 2048, C_CB = 3072, C_CC = 4096, C_CX = 5120, C_GA = 6144, C_GC = 7168;
__host__ __device__ constexpr size_t PL(int C) { return (size_t)(C / 1024) * (size_t)(2 * 8192) * 1024; }
constexpr float RMS_EPS = 1e-6f, SUBLN_EPS = 1e-5f, LAMBDA_INIT = 0.2f;
constexpr float SW_LIMIT = 7.0f, SW_ALPHA = 1.702f;
constexpr float LOG2E = 1.4426950408889634f;
constexpr float QSCALE = 0.125f * LOG2E;
constexpr int ECAP = 16384;
constexpr int MAXTILES = 320;
constexpr int SLOT_ROWS = MAXTILES * 256;

constexpr size_t MiB = 1u << 20;
constexpr size_t WS_CTL = 0, CTL_ZERO_BYTES = 1 * MiB;
constexpr size_t WS_MODP = 1 * MiB;
constexpr size_t WS_MOD = 2 * MiB;
constexpr size_t WS_ROPE = 3 * MiB;
constexpr size_t WS_LIST = 5 * MiB;
constexpr size_t WS_PAIR = 7 * MiB;
constexpr size_t WS_WAO = 8 * MiB, WS_WCO = 10 * MiB, WS_WOUT = 12 * MiB;
constexpr size_t WS_WIN = 16 * MiB;
constexpr size_t WS_WGU = 32 * MiB;
constexpr size_t WS_WD = 160 * MiB;
constexpr size_t WS_XN = 224 * MiB;
constexpr size_t WS_MM = 256 * MiB;
constexpr size_t WS_PROJ = 288 * MiB;
constexpr size_t WS_ACT = 544 * MiB;
constexpr size_t WS_Z = WS_ACT;
constexpr size_t WS_ON = WS_ACT + 32 * MiB;
constexpr size_t WS_Y = 704 * MiB;
constexpr size_t WS_KT = 864 * MiB;
constexpr size_t WS_VT = 896 * MiB;
constexpr size_t WS_XN8 = 928 * MiB;
constexpr size_t WS_Q8 = 944 * MiB;
constexpr size_t WS_END = 960 * MiB;
constexpr int CW_TMO = 0, CW_CODE = 1;
constexpr int CW_KMAX = 128;
constexpr int CW_CNT = 64;
constexpr int CW_BAR = 4096;

constexpr int RING_BYTES = 131072;
constexpr int TBL_OFF = 136192;
constexpr int WSF_OFF = 141312;
constexpr int MISC_OFF = 143360;
constexpr int LDS_BYTES = 147456;

#define RLX_AGENT __ATOMIC_RELAXED, __HIP_MEMORY_SCOPE_AGENT
#define LDS_WAIT() asm volatile("s_waitcnt lgkmcnt(0)" ::: "memory")
#define VM_WAIT() asm volatile("s_waitcnt vmcnt(0)" ::: "memory")

__device__ __forceinline__ unsigned f2bf(float f) { unsigned u = __builtin_bit_cast(unsigned, f); return (u + 0x7fffu + ((u >> 16) & 1u)) >> 16; }
__device__ __forceinline__ unsigned pk2(float lo, float hi) { return f2bf(lo) | (f2bf(hi) << 16); }
__device__ __forceinline__ float bflo(unsigned w) { return __builtin_bit_cast(float, w << 16); }
__device__ __forceinline__ float bfhi(unsigned w) { return __builtin_bit_cast(float, w & 0xffff0000u); }
__device__ __forceinline__ unsigned cvt_pk_bf16(float lo, float hi) { unsigned r; asm volatile("v_cvt_pk_bf16_f32 %0, %1, %2" : "=v"(r) : "v"(lo), "v"(hi)); return r; }
__device__ __forceinline__ float sigmoidf_fast(float v) { return __builtin_amdgcn_rcpf(1.0f + __builtin_amdgcn_exp2f(-LOG2E * v)); }
__device__ __forceinline__ int lane_opaque() { int l; asm volatile("v_mbcnt_lo_u32_b32 %0, -1, 0\n\tv_mbcnt_hi_u32_b32 %0, -1, %0" : "=v"(l)); return l; }
__device__ __forceinline__ void store16_wt(void* p, u32x4 v) { asm volatile("global_store_dwordx4 %0, %1, off sc1\n\ts_nop 1" :: "v"(p), "v"(v) : "memory"); }
__device__ __forceinline__ float wave_sum(float v) {
#pragma unroll
    for (int o = 1; o < 64; o <<= 1) v += __shfl_xor(v, o);
    return v;
}

namespace pg8 {
constexpr int BM = 256, BK = 64, HALF = 128, HTB = HALF * BK * 2, STAGE_BYTES = 8 * HTB, NXCD = 8, WGM = 8;
__host__ __device__ __forceinline__ int lds_byte(int r, int c) { const int st = (r >> 4) * 2 + (c >> 5), rr = r & 15, cc = c & 31, ob = rr * 64 + cc * 2; return st * 1024 + (ob ^ (((ob >> 9) & 1) << 5)); }
__host__ __device__ __forceinline__ void stage_rc(int b, int& R, int& C) { const int st = b / 1024, sb = b % 1024, swz = sb ^ (((sb >> 9) & 1) << 5); R = (st >> 1) * 16 + swz / 64; C = (st & 1) * 32 + (swz % 64) / 2; }
__host__ __device__ __forceinline__ int perm32(int rho) { const int n = rho >> 4, i = rho & 15; return 8 * (i >> 2) + 4 * n + (i & 3); }

struct Unit { int pm, pn, e; };
struct Gemm { const bf16_t* A; const bf16_t* Bt; int lda, K; size_t bstride; };

struct StaticOrder {
    int nM, nN, nwg, G, c;
    __device__ void init(int Mr, int N, int G_, int c_) { nM = Mr / BM; nN = N / BM; nwg = nM * nN; G = G_; c = c_; }
    __device__ bool next(int i, Unit& u) const {
        const long L = (long)i * G + c; if (L >= nwg) return false;
        int wgid = (int)L; { const int q = nwg / NXCD, r = nwg % NXCD, xcd = wgid % NXCD, off = wgid / NXCD; wgid = (xcd < r ? xcd * (q + 1) : r * (q + 1) + (xcd - r) * q) + off; }
        const int nig = WGM * nN, gid = wgid / nig, fm = gid * WGM, gsz = (nM - fm) < WGM ? (nM - fm) : WGM;
        u.pm = fm + ((wgid % nig) % gsz); u.pn = (wgid % nig) / gsz; u.e = 0; return true;
    }
    __device__ __forceinline__ int arow(const Unit& u, int r) const { return u.pm * BM + r; }
    __device__ __forceinline__ int acol(const Unit&) const { return 0; }
};

template <class Epi, class Sched, bool ALIGN_EPI, bool FP8 = false>
__device__ __forceinline__ void gemm_phase(LAS unsigned char* lds, const Gemm g, const Sched& S, const Epi& E, int wid_in) {
    const int wid = __builtin_amdgcn_readfirstlane(wid_in), lane = lane_opaque(), tid = wid * 64 + lane, wr = wid >> 2, wc = wid & 3, fr = lane & 15, fq = lane >> 4;
    const int K = g.K, nt = K / BK, lda = g.lda;
    unsigned voffB[2];
#pragma unroll
    for (int i = 0; i < 2; ++i) { int R, C; stage_rc(tid * 16 + i * 8192, R, C); const int Rb = (R & ~31) + perm32(R & 31);
        voffB[i] = (unsigned)(Rb * K + C) * 2u; }
    const size_t kstep = (size_t)(BK * 2);
    const size_t hstepB = (size_t)HALF * K * 2;
    const size_t tstepB = 2 * hstepB;
    const unsigned ldsw = (unsigned)wid * 1024u;
    const int aoff = lds_byte(wr * 64 + fr, FP8 ? fq * 16 : fq * 8), boff = lds_byte(wc * 32 + fr, FP8 ? fq * 16 : fq * 8);
    const int aoff1 = lds_byte(wr * 64 + fr, fq * 16 + 8), boff1 = lds_byte(wc * 32 + fr, fq * 16 + 8);
#define PG8_SA(b, h) (((b) * 2 + (h)) * HTB)
#define PG8_SB(b, h) ((4 + (b) * 2 + (h)) * HTB)
#define PG8_STAGE(bufoff, gbase, voff) do { _Pragma("unroll") for (int _i = 0; _i < 2; ++_i) \
        __builtin_amdgcn_global_load_lds((const unsigned*)((const char*)(gbase) + (voff)[_i]), (LAS unsigned*)(lds + (bufoff) + ldsw + _i * 8192), 16, 0, 0); } while (0)
#define PG8_LD8(p0, p1) __builtin_shufflevector(*(const LAS v4i*)(p0), *(const LAS v4i*)(p1), 0, 1, 2, 3, 4, 5, 6, 7)
#define PG8_LDA(dst, b, h) do { if constexpr (FP8) { _Pragma("unroll") for (int m = 0; m < 4; ++m) dst##8[m] = PG8_LD8(lds + PG8_SA(b, h) + aoff + m * 2048, lds + PG8_SA(b, h) + aoff1 + m * 2048); } \
        else { _Pragma("unroll") for (int m = 0; m < 4; ++m) _Pragma("unroll") for (int k = 0; k < 2; ++k) dst[m][k] = *(const LAS bf16x8*)(lds + PG8_SA(b, h) + aoff + m * 2048 + k * 1024); } } while (0)
#define PG8_LDB(dst, b, h) do { if constexpr (FP8) { _Pragma("unroll") for (int n = 0; n < 2; ++n) dst##8[n] = PG8_LD8(lds + PG8_SB(b, h) + boff + n * 2048, lds + PG8_SB(b, h) + boff1 + n * 2048); } \
        else { _Pragma("unroll") for (int n = 0; n < 2; ++n) _Pragma("unroll") for (int k = 0; k < 2; ++k) dst[n][k] = *(const LAS bf16x8*)(lds + PG8_SB(b, h) + boff + n * 2048 + k * 1024); } } while (0)
#define PG8_MMA(ai, bj, At, Bt) do { __builtin_amdgcn_s_setprio(1); _Pragma("unroll") for (int m = 0; m < 4; ++m) _Pragma("unroll") for (int n = 0; n < 2; ++n) { \
        if constexpr (FP8) { asm volatile("v_mfma_scale_f32_16x16x128_f8f6f4 %0, %1, %2, %0, %3, %4 op_sel_hi:[0,0,0]" : "+v"(acc[ai][bj][m][n]) : "v"(Bt##8[n]), "v"(At##8[m]), "v"(sclW), "v"(sclX)); } \
        else { _Pragma("unroll") for (int k = 0; k < 2; ++k) acc[ai][bj][m][n] = __builtin_amdgcn_mfma_f32_16x16x32_bf16(Bt[n][k], At[m][k], acc[ai][bj][m][n], 0, 0, 0); } } __builtin_amdgcn_s_setprio(0); } while (0)
#define PG8_WAIT_V(n) asm volatile("s_waitcnt vmcnt(" #n ")" ::: "memory")
#define PG8_WAIT_L(n) asm volatile("s_waitcnt lgkmcnt(" #n ")" ::: "memory")
#define PG8_BAR __builtin_amdgcn_s_barrier()
#define PG8_SCHED __builtin_amdgcn_sched_barrier(0)
#define PG8_AOFF(dst, u) do { const int _t = wid * 64 + lane_opaque(); _Pragma("unroll") for (int _i = 0; _i < 2; ++_i) { int _R, _C; stage_rc(_t * 16 + _i * 8192, _R, _C); \
        _Pragma("unroll") for (int _h = 0; _h < 2; ++_h) dst[_h][_i] = ((unsigned)S.arow(u, _h * HALF + _R) * (unsigned)lda + (unsigned)(_C + S.acol(u))) * 2u; } } while (0)
    Unit cur, nxt; int ui = 0;
    if (!S.next(0, cur)) return;
    f32x4 acc[2][2][4][2];
#pragma unroll
    for (int a = 0; a < 2; ++a)
#pragma unroll
        for (int b = 0; b < 2; ++b)
#pragma unroll
            for (int m = 0; m < 4; ++m)
#pragma unroll
                for (int n = 0; n < 2; ++n) acc[a][b][m][n] = (f32x4){0.f, 0.f, 0.f, 0.f};
    bf16x8 At[4][2], B0[2][2], B1[2][2]; v8i At8[4], B08[2], B18[2]; int sclW = FP8_SCALE_W, sclX = FP8_SCALE_ONE; asm volatile("" : "+v"(sclW), "+v"(sclX));
    unsigned ca[2][2], na[2][2];
    PG8_AOFF(ca, cur);
    const char* const Ab = (const char*)g.A;
    const char* cB = (const char*)g.Bt + ((size_t)cur.e * g.bstride) * 2 + (size_t)cur.pn * tstepB;
    PG8_STAGE(PG8_SB(0, 0), cB, voffB); PG8_STAGE(PG8_SB(0, 1), cB + hstepB, voffB); PG8_STAGE(PG8_SA(0, 0), Ab, ca[0]); PG8_STAGE(PG8_SA(0, 1), Ab, ca[1]);
    if (wr == 1) PG8_BAR;
    PG8_WAIT_V(2); PG8_BAR;
    PG8_STAGE(PG8_SB(1, 0), cB + kstep, voffB); PG8_STAGE(PG8_SA(1, 0), Ab + kstep, ca[0]); PG8_STAGE(PG8_SB(1, 1), cB + hstepB + kstep, voffB);
    PG8_WAIT_V(6); PG8_BAR;
    for (;;) {
        const bool has_next = S.next(ui + 1, nxt);
        if (has_next) { PG8_AOFF(na, nxt); } else {
#pragma unroll
            for (int h = 0; h < 2; ++h)
#pragma unroll
                for (int i = 0; i < 2; ++i) na[h][i] = ca[h][i]; }
        const char* nB = has_next ? (const char*)g.Bt + ((size_t)nxt.e * g.bstride) * 2 + (size_t)nxt.pn * tstepB : cB;
        for (int t = 0; t < nt; t += 2) {
            const bool last = (t == nt - 2);
            const size_t k1 = (size_t)(t + 1) * kstep;
            const size_t k2 = last ? 0 : (size_t)(t + 2) * kstep, k3 = k2 + kstep;
            const char* b2 = last ? nB : cB + (size_t)(t + 2) * kstep; const char* b3 = b2 + kstep;
            unsigned s2[2][2];
#pragma unroll
            for (int h = 0; h < 2; ++h)
#pragma unroll
                for (int i = 0; i < 2; ++i) s2[h][i] = last ? na[h][i] : ca[h][i];
            PG8_LDB(B0, 0, 0); PG8_LDB(B1, 0, 1); PG8_SCHED; PG8_LDA(At, 0, 0); PG8_STAGE(PG8_SA(1, 1), Ab + k1, ca[1]);
            PG8_WAIT_V(8); PG8_WAIT_L(0); PG8_BAR; PG8_MMA(0, 0, At, B0); PG8_MMA(0, 1, At, B1); PG8_BAR; PG8_SCHED;
            PG8_LDA(At, 0, 1); PG8_STAGE(PG8_SB(0, 0), b2, voffB); PG8_STAGE(PG8_SB(0, 1), b2 + hstepB, voffB); PG8_STAGE(PG8_SA(0, 0), Ab + k2, s2[0]);
            PG8_WAIT_V(8); PG8_WAIT_L(0); PG8_BAR; PG8_MMA(1, 0, At, B0); PG8_MMA(1, 1, At, B1); PG8_BAR; PG8_SCHED;
            PG8_LDB(B0, 1, 0); PG8_LDB(B1, 1, 1); PG8_SCHED; PG8_LDA(At, 1, 0); PG8_STAGE(PG8_SA(0, 1), Ab + k2, s2[1]);
            PG8_WAIT_V(8); PG8_WAIT_L(0); PG8_BAR; PG8_MMA(0, 0, At, B0); PG8_MMA(0, 1, At, B1); PG8_BAR; PG8_SCHED;
            PG8_LDA(At, 1, 1); PG8_STAGE(PG8_SB(1, 0), b3, voffB); PG8_STAGE(PG8_SB(1, 1), b3 + hstepB, voffB); PG8_STAGE(PG8_SA(1, 0), Ab + k3, s2[0]);
            PG8_WAIT_V(8); PG8_WAIT_L(0); PG8_BAR; PG8_MMA(1, 0, At, B0); PG8_MMA(1, 1, At, B1); PG8_BAR; PG8_SCHED;
        }
        if constexpr (ALIGN_EPI) { if (wr == 0) PG8_BAR; }
        if constexpr (FP8) asm volatile("s_nop 15\n\ts_nop 15" ::: "memory");
        if constexpr (Epi::CHAIN) {
            if (has_next) { E.mid(acc, cur, wr, wc, fr, fq); } else { E(acc, cur, wr, wc, fr, fq); }
            if (!has_next) break;
        } else {
        E(acc, cur, wr, wc, fr, fq);
        if (!has_next) break;
#pragma unroll
        for (int a = 0; a < 2; ++a)
#pragma unroll
            for (int b = 0; b < 2; ++b)
#pragma unroll
                for (int m = 0; m < 4; ++m)
#pragma unroll
                    for (int n = 0; n < 2; ++n) acc[a][b][m][n] = (f32x4){0.f, 0.f, 0.f, 0.f};
        }
        cur = nxt; cB = nB; ++ui;
#pragma unroll
        for (int h = 0; h < 2; ++h)
#pragma unroll
            for (int i = 0; i < 2; ++i) ca[h][i] = na[h][i];
        if constexpr (ALIGN_EPI) { if (wr == 1) PG8_BAR; }
    }
    PG8_WAIT_V(0);
    if constexpr (!ALIGN_EPI) { if (wr == 0) PG8_BAR; }
    PG8_BAR;
#undef PG8_SA
#undef PG8_SB
#undef PG8_STAGE
#undef PG8_LDA
#undef PG8_LDB
#undef PG8_MMA
#undef PG8_LD8
#undef PG8_WAIT_V
#undef PG8_WAIT_L
#undef PG8_BAR
#undef PG8_SCHED
#undef PG8_AOFF
}

struct EpiStore {
    static constexpr bool CHAIN = false;
    bf16_t* O; int ldc; const float* bias; int bias_stride; int pn_split, col_lo, col_hi;
    __device__ __forceinline__ void operator()(const f32x4 (&acc)[2][2][4][2], const Unit& u, int wr, int wc, int fr, int fq) const {
        const int row0 = u.pm * BM + wr * 64 + fr, col0 = (u.pn < pn_split ? col_lo + u.pn * BM : col_hi + (u.pn - pn_split) * BM) + wc * 32 + 8 * fq;
        f32x4 bv[2][2];
#pragma unroll
        for (int bj = 0; bj < 2; ++bj)
#pragma unroll
            for (int n = 0; n < 2; ++n) bv[bj][n] = bias ? *(const f32x4*)(bias + (size_t)u.e * bias_stride + col0 + bj * HALF + 4 * n) : (f32x4){0.f, 0.f, 0.f, 0.f};
#pragma unroll
        for (int ai = 0; ai < 2; ++ai)
#pragma unroll
            for (int m = 0; m < 4; ++m) { bf16_t* rowp = ldc ? O + (size_t)(row0 + ai * HALF + m * 16) * ldc + col0 : O + PL(col0) + (size_t)(row0 + ai * HALF + m * 16) * D + (col0 & 1023);
#pragma unroll
                for (int bj = 0; bj < 2; ++bj) { const f32x4 v0 = acc[ai][bj][m][0] + bv[bj][0], v1 = acc[ai][bj][m][1] + bv[bj][1];
                    u32x4 w; w.x = cvt_pk_bf16(v0[0], v0[1]); w.y = cvt_pk_bf16(v0[2], v0[3]); w.z = cvt_pk_bf16(v1[0], v1[1]); w.w = cvt_pk_bf16(v1[2], v1[3]);
                    store16_wt(rowp + bj * HALF, w); } }
    }
};
__device__ __forceinline__ float rowsum4(float x) {
    const auto p = __builtin_amdgcn_permlane16_swap(__float_as_uint(x), __float_as_uint(x), false, false); x = __uint_as_float(p[0]) + __uint_as_float(p[1]);
    const auto q = __builtin_amdgcn_permlane32_swap(__float_as_uint(x), __float_as_uint(x), false, false); return __uint_as_float(q[0]) + __uint_as_float(q[1]); }
struct EpiInProj {
    static constexpr bool CHAIN = false;
    EpiStore st; const float* qnw; const float* knw; const f32x2* cs; unsigned char* q8; unsigned char* kimg; unsigned* kmax; unsigned char* vimg;
    __device__ __forceinline__ void operator()(const f32x4 (&acc)[2][2][4][2], const Unit& u, int wr, int wc, int fr_, int fq_) const {
        (void)fr_; (void)fq_; const int lo_ = lane_opaque(), fr = lo_ & 15, fq = lo_ >> 4;
        if (u.pn >= 12) { st(acc, u, wr, wc, fr, fq); return; }
        if (u.pn >= 8) {
            const int T = 2 * wr + (fr >> 3), ks = (fr >> 1) & 3, hf = fr & 1, row0 = u.pm * BM, bb = row0 >> 13, tile = ((row0 & (SEQ - 1)) >> 6) + T;
#pragma unroll
            for (int bj = 0; bj < 2; ++bj) { const int hh = 2 * (u.pn - 8) + bj;
                unsigned char* vd = vimg + ((size_t)((bb * 8 + hh) * (SEQ / 64) + tile)) * 8192 + (size_t)wc * 2048 + hf * 1024 + 8 * ks;
#pragma unroll
                for (int n = 0; n < 2; ++n)
#pragma unroll
                    for (int jj = 0; jj < 4; ++jj) { const int dd = 8 * fq + 4 * n + jj; u32x2 o;
                        o.x = cvt4_fp8(acc[0][bj][0][n][jj], acc[0][bj][1][n][jj], acc[0][bj][2][n][jj], acc[0][bj][3][n][jj]);
                        o.y = cvt4_fp8(acc[1][bj][0][n][jj], acc[1][bj][1][n][jj], acc[1][bj][2][n][jj], acc[1][bj][3][n][jj]);
                        *(u32x2*)(vd + dd * 32) = o; } }
            return; }
        const int which = u.pn >> 2, grp = (u.pn & 3) * 4 + wc;
        const float* nw = which == 0 ? qnw : knw; const float osc = which == 0 ? QSCALE * 8.0f : 1.0f, n2s = which == 0 ? 1.0f / 64.0f : 1.0f;
        float w1[8], w2[8]; float kmax2 = 0.f;
#pragma unroll
        for (int j = 0; j < 8; ++j) { w1[j] = nw[8 * fq + j] * osc; w2[j] = nw[32 + 8 * fq + j] * osc; }
        const int rowb = u.pm * BM + wr * 64 + fr;
        f32x4 cvn[4];
        { const f32x4* cp = (const f32x4*)(cs + (size_t)(rowb & (SEQ - 1)) * 32 + 8 * fq);
#pragma unroll
          for (int jj = 0; jj < 4; ++jj) cvn[jj] = cp[jj]; }
#pragma unroll
        for (int ai = 0; ai < 2; ++ai)
#pragma unroll
            for (int m = 0; m < 4; ++m) { const int row = rowb + ai * HALF + m * 16, t = row & (SEQ - 1);
                const f32x4 a0 = acc[ai][0][m][0], a1 = acc[ai][0][m][1], c0 = acc[ai][1][m][0], c1 = acc[ai][1][m][1];
                const float t1[8] = {a0[0], a0[1], a0[2], a0[3], a1[0], a1[1], a1[2], a1[3]}, t2[8] = {c0[0], c0[1], c0[2], c0[3], c1[0], c1[1], c1[2], c1[3]};
                float ss = 0.f;
#pragma unroll
                for (int j = 0; j < 8; ++j) ss += t1[j] * t1[j] + t2[j] * t2[j];
                ss = rowsum4(ss);
                const float rstd = 1.0f / sqrtf(ss * (1.0f / 64.0f) + RMS_EPS);
                float o1[8], o2[8];
#pragma unroll
                for (int jj = 0; jj < 4; ++jj) { const f32x4 cv = cvn[jj];
#pragma unroll
                    for (int q = 0; q < 2; ++q) { const int j = 2 * jj + q; const float co = q ? cv[2] : cv[0], si = q ? cv[3] : cv[1];
                        const float u1 = t1[j] * rstd * w1[j], u2 = t2[j] * rstd * w2[j];
                        o1[j] = u1 * co - u2 * si; o2[j] = u2 * co + u1 * si; } }
                __builtin_amdgcn_sched_barrier(0);
                if (ai * 4 + m < 7) { const int rn = rowb + ((ai * 4 + m + 1) >> 2) * HALF + ((ai * 4 + m + 1) & 3) * 16; const f32x4* cp = (const f32x4*)(cs + (size_t)(rn & (SEQ - 1)) * 32 + 8 * fq);
#pragma unroll
                    for (int jj = 0; jj < 4; ++jj) cvn[jj] = cp[jj]; }
                u32x2 wa, wc2;
                wa.x = cvt4_fp8(o1[0], o1[1], o1[2], o1[3]); wa.y = cvt4_fp8(o1[4], o1[5], o1[6], o1[7]);
                wc2.x = cvt4_fp8(o2[0], o2[1], o2[2], o2[3]); wc2.y = cvt4_fp8(o2[4], o2[5], o2[6], o2[7]);
                { float n2 = 0.f;
#pragma unroll
                    for (int j = 0; j < 8; ++j) n2 += o1[j] * o1[j] + o2[j] * o2[j];
                    n2 = rowsum4(n2); kmax2 = fmaxf(kmax2, n2); }
                if (which == 0) { unsigned char* qd = q8 + (size_t)row * D + 64 * grp + 8 * fq; *(u32x2*)qd = wa; *(u32x2*)(qd + 32) = wc2; }
                else { const int bb = row >> 13, key = t, hh = grp >> 1, cmp = grp & 1;
                    unsigned char* kd = kimg + ((size_t)((bb * 8 + hh) * (SEQ / 64) + (key >> 6))) * 8192 + cmp * 4096 + ((key & 63) >> 5) * 2048 + (key & 31) * 32 + 8 * fq;
                    *(u32x2*)kd = wa; *(u32x2*)(kd + 1024) = wc2; } }
        kmax2 = fmaxf(kmax2, __shfl_xor(kmax2, 1)); kmax2 = fmaxf(kmax2, __shfl_xor(kmax2, 2)); kmax2 = fmaxf(kmax2, __shfl_xor(kmax2, 4)); kmax2 = fmaxf(kmax2, __shfl_xor(kmax2, 8));
        if (fr == 0 && fq == 0) atomicMax(kmax + which * 32 + ((u.pm * BM) >> 13) * 16 + grp, __float_as_uint(kmax2 * n2s));
    }
};
template <bool ADD> struct EpiGate {
    static constexpr bool CHAIN = false;
    bf16_t* O; const bf16_t* gate; int ldg;
    __device__ __forceinline__ void operator()(const f32x4 (&acc)[2][2][4][2], const Unit& u, int wr, int wc, int fr, int fq) const {
        const int row0 = u.pm * BM + wr * 64 + fr, col0 = u.pn * BM + wc * 32 + 8 * fq;
#pragma unroll
        for (int ai = 0; ai < 2; ++ai)
#pragma unroll
            for (int m = 0; m < 4; ++m) { const size_t row = (size_t)(row0 + ai * HALF + m * 16);
#pragma unroll
                for (int bj = 0; bj < 2; ++bj) {
                    const u32x4 gv = *(const u32x4*)(gate + row * ldg + col0 + bj * HALF);
                    bf16_t* op = O + row * D + col0 + bj * HALF;
                    const f32x4 a0 = acc[ai][bj][m][0], a1 = acc[ai][bj][m][1];
                    float r[8];
                    r[0] = sigmoidf_fast(bflo(gv.x)) * a0[0]; r[1] = sigmoidf_fast(bfhi(gv.x)) * a0[1]; r[2] = sigmoidf_fast(bflo(gv.y)) * a0[2]; r[3] = sigmoidf_fast(bfhi(gv.y)) * a0[3];
                    r[4] = sigmoidf_fast(bflo(gv.z)) * a1[0]; r[5] = sigmoidf_fast(bfhi(gv.z)) * a1[1]; r[6] = sigmoidf_fast(bflo(gv.w)) * a1[2]; r[7] = sigmoidf_fast(bfhi(gv.w)) * a1[3];
                    if (ADD) { const u32x4 pv = *(const u32x4*)op;
                        r[0] += bflo(pv.x); r[1] += bfhi(pv.x); r[2] += bflo(pv.y); r[3] += bfhi(pv.y); r[4] += bflo(pv.z); r[5] += bfhi(pv.z); r[6] += bflo(pv.w); r[7] += bfhi(pv.w); }
                    u32x4 w; w.x = cvt_pk_bf16(r[0], r[1]); w.y = cvt_pk_bf16(r[2], r[3]); w.z = cvt_pk_bf16(r[4], r[5]); w.w = cvt_pk_bf16(r[6], r[7]);
                    *(u32x4*)op = w; } }
    }
};
struct EpiGateChain {
    static constexpr bool CHAIN = true;
    bf16_t* O; const bf16_t* ga; const bf16_t* gc; int ldg;
    __device__ __forceinline__ void mid(f32x4 (&acc)[2][2][4][2], const Unit& u, int wr, int wc, int fr, int fq) const {
        const int row0 = u.pm * BM + wr * 64 + fr, col0 = u.pn * BM + wc * 32 + 8 * fq;
#pragma unroll
        for (int ai = 0; ai < 2; ++ai) { u32x4 avv[4][2], cvv[4][2];
#pragma unroll
            for (int m = 0; m < 4; ++m)
#pragma unroll
                for (int bj = 0; bj < 2; ++bj) { const size_t o = (size_t)(row0 + ai * HALF + m * 16) * ldg + col0 + bj * HALF; avv[m][bj] = *(const u32x4*)(ga + o); cvv[m][bj] = *(const u32x4*)(gc + o); }
            __builtin_amdgcn_sched_barrier(0);
#pragma unroll
            for (int m = 0; m < 4; ++m)
#pragma unroll
                for (int bj = 0; bj < 2; ++bj) { const u32x4 av = avv[m][bj], cv = cvv[m][bj];
                    const float a8[8] = {bflo(av.x), bfhi(av.x), bflo(av.y), bfhi(av.y), bflo(av.z), bfhi(av.z), bflo(av.w), bfhi(av.w)};
                    const float c8[8] = {bflo(cv.x), bfhi(cv.x), bflo(cv.y), bfhi(cv.y), bflo(cv.z), bfhi(cv.z), bflo(cv.w), bfhi(cv.w)};
#pragma unroll
                    for (int e = 0; e < 8; ++e) { const float r = sigmoidf_fast(c8[e]) * (1.0f + __builtin_amdgcn_exp2f(-LOG2E * fmaxf(a8[e], -60.0f)));
                        if (e < 4) acc[ai][bj][m][0][e] *= r; else acc[ai][bj][m][1][e - 4] *= r; } }
            __builtin_amdgcn_sched_barrier(0); }
    }
    __device__ __forceinline__ void operator()(const f32x4 (&acc)[2][2][4][2], const Unit& u, int wr, int wc, int fr, int fq) const {
        const int row0 = u.pm * BM + wr * 64 + fr, col0 = u.pn * BM + wc * 32 + 8 * fq;
        u32x4 avv[2][4][2];
#pragma unroll
        for (int ai = 0; ai < 2; ++ai)
#pragma unroll
            for (int m = 0; m < 4; ++m)
#pragma unroll
                for (int bj = 0; bj < 2; ++bj) avv[ai][m][bj] = *(const u32x4*)(ga + (size_t)(row0 + ai * HALF + m * 16) * ldg + col0 + bj * HALF);
        __builtin_amdgcn_sched_barrier(0);
#pragma unroll
        for (int ai = 0; ai < 2; ++ai)
#pragma unroll
            for (int m = 0; m < 4; ++m) { const size_t row = (size_t)(row0 + ai * HALF + m * 16);
#pragma unroll
                for (int bj = 0; bj < 2; ++bj) {
                    const u32x4 av = avv[ai][m][bj];
                    const float a8[8] = {bflo(av.x), bfhi(av.x), bflo(av.y), bfhi(av.y), bflo(av.z), bfhi(av.z), bflo(av.w), bfhi(av.w)};
                    const f32x4 a0 = acc[ai][bj][m][0], a1 = acc[ai][bj][m][1]; float r[8];
#pragma unroll
                    for (int e = 0; e < 8; ++e) r[e] = sigmoidf_fast(fmaxf(a8[e], -60.0f)) * (e < 4 ? a0[e] : a1[e - 4]);
                    u32x4 w; w.x = cvt_pk_bf16(r[0], r[1]); w.y = cvt_pk_bf16(r[2], r[3]); w.z = cvt_pk_bf16(r[4], r[5]); w.w = cvt_pk_bf16(r[6], r[7]);
                    *(u32x4*)(O + row * D + col0 + bj * HALF) = w; } }
    }
};
struct EpiResid {
    static constexpr bool CHAIN = false;
    const float* x; float* out; const float* g;
    __device__ __forceinline__ void operator()(const f32x4 (&acc)[2][2][4][2], const Unit& u, int wr, int wc, int fr, int fq) const {
        const int row0 = u.pm * BM + wr * 64 + fr, col0 = u.pn * BM + wc * 32 + 8 * fq;
        const float* gb = g + (u.pm >= (SEQ / BM) ? 6144 : 0);
        f32x4 gv[2][2];
#pragma unroll
        for (int bj = 0; bj < 2; ++bj)
#pragma unroll
            for (int n = 0; n < 2; ++n) gv[bj][n] = *(const f32x4*)(gb + col0 + bj * HALF + 4 * n);
#pragma unroll
        for (int ai = 0; ai < 2; ++ai) { f32x4 xv[4][2][2];
#pragma unroll
            for (int m = 0; m < 4; ++m)
#pragma unroll
                for (int bj = 0; bj < 2; ++bj)
#pragma unroll
                    for (int n = 0; n < 2; ++n) xv[m][bj][n] = *(const f32x4*)(x + (size_t)(row0 + ai * HALF + m * 16) * D + col0 + bj * HALF + 4 * n);
            __builtin_amdgcn_sched_barrier(0);
#pragma unroll
            for (int m = 0; m < 4; ++m) { const size_t off = (size_t)(row0 + ai * HALF + m * 16) * D + col0;
#pragma unroll
                for (int bj = 0; bj < 2; ++bj)
#pragma unroll
                    for (int n = 0; n < 2; ++n) *(f32x4*)(out + off + bj * HALF + 4 * n) = xv[m][bj][n] + gv[bj][n] * acc[ai][bj][m][n]; }
            __builtin_amdgcn_sched_barrier(0); }
    }
};
struct EpiSwiglu {
    static constexpr bool CHAIN = false;
    unsigned char* O; const float* bias;
    __device__ __forceinline__ void operator()(const f32x4 (&acc)[2][2][4][2], const Unit& u, int wr, int wc, int fr, int fq) const {
        const int row0 = u.pm * BM + wr * 64 + fr, col0 = u.pn * BM + wc * 32 + 8 * fq;
        f32x4 bv[2][2];
#pragma unroll
        for (int bj = 0; bj < 2; ++bj)
#pragma unroll
            for (int n = 0; n < 2; ++n) bv[bj][n] = *(const f32x4*)(bias + (size_t)u.e * (2 * DFF) + col0 + bj * HALF + 4 * n);
#pragma unroll
        for (int ai = 0; ai < 2; ++ai)
#pragma unroll
            for (int m = 0; m < 4; ++m) { unsigned char* rowp = O + (size_t)(row0 + ai * HALF + m * 16) * DFF + (col0 >> 1);
#pragma unroll
                for (int bj = 0; bj < 2; ++bj) { const f32x4 v0 = acc[ai][bj][m][0] + bv[bj][0], v1 = acc[ai][bj][m][1] + bv[bj][1];
                    float r[4];
#pragma unroll
                    for (int p = 0; p < 4; ++p) { const float gt = p < 2 ? v0[2 * p] : v1[2 * p - 4], up = p < 2 ? v0[2 * p + 1] : v1[2 * p - 3];
                        const float gc = fminf(gt, SW_LIMIT), uc = __builtin_amdgcn_fmed3f(up, -SW_LIMIT, SW_LIMIT);
                        const float z = gc * __builtin_amdgcn_rcpf(1.0f + __builtin_amdgcn_exp2f(gc * (-LOG2E * SW_ALPHA)));
                        r[p] = __builtin_fmaf(uc, z, z); }
                    int w8 = __builtin_amdgcn_cvt_pk_fp8_f32(r[0], r[1], 0, false); w8 = __builtin_amdgcn_cvt_pk_fp8_f32(r[2], r[3], w8, true);
                    *(unsigned*)(rowp + bj * (HALF / 2)) = (unsigned)w8; } }
    }
};
}

namespace attn {
constexpr int PITCH = INW;
constexpr int KVBLK = 64, NT = SEQ / KVBLK, NTB = NT / 2, NSLOT = 3, SLOTB = 16384;
constexpr int VSLOTB = 8192;
constexpr int LDS_K = 0, LDS_V = NSLOT * SLOTB;
constexpr int XROW = 132;
constexpr int XIMG = 32 * XROW * 4;
static_assert(8 * XIMG <= TBL_OFF && LDS_V + NSLOT * SLOTB <= RING_BYTES, "attention LDS map");
__device__ __forceinline__ int crow(int r, int hi) { return (r & 3) + 8 * (r >> 2) + 4 * hi; }
__device__ __forceinline__ void glds16(const void* gsrc, unsigned lds_dst) { unsigned keep;
    asm volatile("s_mov_b32 %0, m0\n\ts_mov_b32 m0, %2\n\ts_nop 0\n\tglobal_load_lds_dwordx4 %1, off\n\ts_mov_b32 m0, %0" : "=&s"(keep) : "v"(gsrc), "s"(lds_dst) : "memory"); }
__device__ __forceinline__ void glds16x2(const void* gsrc, unsigned lds_dst) { unsigned keep;
    asm volatile("s_mov_b32 %0, m0\n\ts_mov_b32 m0, %2\n\ts_nop 0\n\tglobal_load_lds_dwordx4 %1, off\n\tglobal_load_lds_dwordx4 %1, off offset:1024\n\ts_mov_b32 m0, %0" : "=&s"(keep) : "v"(gsrc), "s"(lds_dst) : "memory"); }
__device__ __forceinline__ void glds16x4(const void* gsrc, unsigned lds_dst) { unsigned keep;
    asm volatile("s_mov_b32 %0, m0\n\ts_mov_b32 m0, %2\n\ts_nop 0\n\tglobal_load_lds_dwordx4 %1, off\n\tglobal_load_lds_dwordx4 %1, off offset:1024\n\tglobal_load_lds_dwordx4 %1, off offset:2048\n\tglobal_load_lds_dwordx4 %1, off offset:3072\n\ts_mov_b32 m0, %0" : "=&s"(keep) : "v"(gsrc), "s"(lds_dst) : "memory"); }
typedef LAS const char* lds_cptr;
typedef short v4i16_t __attribute__((ext_vector_type(4)));
__device__ __forceinline__ s16x4 vtr(lds_cptr p) { return __builtin_bit_cast(s16x4, __builtin_amdgcn_ds_read_tr16_b64_v4i16((LAS v4i16_t*)p)); }
typedef __bf16 bf16x2_t __attribute__((ext_vector_type(2)));
__device__ __forceinline__ unsigned cvtpk_s(float lo, float hi) { f32x2 v = {lo, hi}; bf16x2_t b = __builtin_convertvector(v, bf16x2_t); return __builtin_bit_cast(unsigned, b); }
#define ATT_WAIT_BAR(N) asm volatile("s_waitcnt vmcnt(" #N ") lgkmcnt(0)\n\ts_barrier" ::: "memory")

struct AttnState { f32x16 o0, o1, o2, o3; f32x16 p0, p1, p2, p3; v8i pa; f32x16 negm; f32x16 lacc; float mhat, l_reg; };
#define ATT_SB() __builtin_amdgcn_sched_barrier(0)
__device__ __forceinline__ unsigned cvt4_bf8(float a, float b, float c, float d);
#define ATT_LD8(p) __builtin_shufflevector(*(const LAS v4i*)(p), *(const LAS v4i*)((p) + 16), 0, 1, 2, 3, 4, 5, 6, 7)
__device__ __forceinline__ void attn_kload(v8i (&kf)[4], lds_cptr kp) { kf[0] = ATT_LD8(kp); kf[1] = ATT_LD8(kp + 2048); kf[2] = ATT_LD8(kp + 8192); kf[3] = ATT_LD8(kp + 8192 + 2048); }
template <int THRL, bool FAST>
__device__ __forceinline__ void attn_s1(AttnState& st, const v8i (&kf)[4], const v8i& q8, bool first, int r32, int hi) {
    f32x16 p0, p1, p2, p3;
#define ATT_QK(KF, C) __builtin_amdgcn_mfma_scale_f32_32x32x64_f8f6f4(KF, q8, C, 0, 0, 0, FP8_SCALE_ONE, 0, FP8_SCALE_Q)
    if constexpr (FAST) {
        __builtin_amdgcn_s_setprio(1);
        p0 = ATT_QK(kf[0], f32x16{}); p1 = ATT_QK(kf[1], f32x16{}); p2 = ATT_QK(kf[2], f32x16{}); p3 = ATT_QK(kf[3], f32x16{});
        __builtin_amdgcn_s_setprio(0);
#pragma unroll
        for (int r = 0; r < 16; ++r) p0[r] = __builtin_amdgcn_exp2f(p0[r]);
#pragma unroll
        for (int r = 0; r < 16; ++r) p1[r] = __builtin_amdgcn_exp2f(p1[r]);
        { v8i pa;
#pragma unroll
          for (int k = 0; k < 4; ++k) { pa[k] = (int)cvt4_bf8(p0[4 * k], p0[4 * k + 1], p0[4 * k + 2], p0[4 * k + 3]); pa[4 + k] = (int)cvt4_bf8(p1[4 * k], p1[4 * k + 1], p1[4 * k + 2], p1[4 * k + 3]); }
          asm volatile("" : "+v"(pa)); st.pa = pa; }
        st.p0 = p0; st.p1 = p1; st.p2 = p2; st.p3 = p3;
    } else {
    __builtin_amdgcn_s_setprio(1);
    p0 = ATT_QK(kf[0], st.negm); p1 = ATT_QK(kf[1], st.negm); p2 = ATT_QK(kf[2], st.negm); p3 = ATT_QK(kf[3], st.negm);
    __builtin_amdgcn_s_setprio(0);
    {
    float rm;
    { float a = fmaxf(fmaxf(p0[0], p0[1]), p1[0]), c = fmaxf(fmaxf(p0[2], p0[3]), p1[1]); a = fmaxf(fmaxf(a, p1[2]), p1[3]);
#pragma unroll
      for (int r = 4; r < 16; r += 4) { a = fmaxf(fmaxf(a, p0[r]), p0[r + 1]); c = fmaxf(fmaxf(c, p0[r + 2]), p0[r + 3]); a = fmaxf(fmaxf(a, p1[r]), p1[r + 1]); c = fmaxf(fmaxf(c, p1[r + 2]), p1[r + 3]); }
#pragma unroll
      for (int r = 0; r < 16; r += 4) { a = fmaxf(fmaxf(a, p2[r]), p2[r + 1]); c = fmaxf(fmaxf(c, p2[r + 2]), p2[r + 3]); a = fmaxf(fmaxf(a, p3[r]), p3[r + 1]); c = fmaxf(fmaxf(c, p3[r + 2]), p3[r + 3]); }
      rm = fmaxf(a, c); auto rr = __builtin_amdgcn_permlane32_swap(__float_as_uint(rm), __float_as_uint(rm), false, false); rm = fmaxf(__uint_as_float(rr[0]), __uint_as_float(rr[1])); }
    if (first || __any(rm > (float)THRL)) {
        const float dl = first ? rm : fmaxf(rm, 0.f); st.mhat += dl;
#pragma unroll
        for (int r = 0; r < 16; ++r) { p0[r] -= dl; p1[r] -= dl; p2[r] -= dl; p3[r] -= dl; }
#pragma unroll
        for (int r = 0; r < 16; ++r) st.negm[r] = -st.mhat;
        if (!first) {
            const float f = __builtin_amdgcn_exp2f(-dl); st.l_reg *= f;
#pragma unroll
            for (int r = 0; r < 16; ++r) { st.o0[r] *= f; st.o1[r] *= f; st.o2[r] *= f; st.o3[r] *= f; }
        }
    }
    }
#pragma unroll
    for (int r = 0; r < 16; ++r) { p0[r] = __builtin_amdgcn_exp2f(p0[r]); p1[r] = __builtin_amdgcn_exp2f(p1[r]); p2[r] = __builtin_amdgcn_exp2f(p2[r]); p3[r] = __builtin_amdgcn_exp2f(p3[r]); }
    st.p0 = p0; st.p1 = p1; st.p2 = p2; st.p3 = p3;
    }
#undef ATT_QK
}
__device__ __forceinline__ unsigned cvt4_bf8(float a, float b, float c, float d) { int w = __builtin_amdgcn_cvt_pk_bf8_f32(a, b, 0, false); w = __builtin_amdgcn_cvt_pk_bf8_f32(c, d, w, true); return (unsigned)w; }
template <bool FAST>
__device__ __forceinline__ void attn_s2(AttnState& st, lds_cptr vp, v8i (&kf)[4], lds_cptr kpn) {
    int one = FP8_SCALE_ONE; asm volatile("" : "+v"(one));
    float sacc = 0.f;
    v8i ones8; if constexpr (FAST) { int o1 = 0x38383838; asm volatile("" : "+v"(o1)); ones8 = (v8i){o1, o1, o1, o1, o1, o1, o1, o1}; }
#define ATT_MM8(OD, VF, PB) asm volatile("s_nop 1\n\tv_mfma_scale_f32_32x32x64_f8f6f4 %0, %1, %2, %0, %3, %3 op_sel_hi:[0,0,0] blgp:1" : "+v"(OD) : "v"(VF), "v"(PB), "v"(one))
#define ATT_PB(PB, PA, PC) do { _Pragma("unroll") for (int k = 0; k < 4; ++k) { PB[k] = (int)cvt4_bf8(PA[4 * k], PA[4 * k + 1], PA[4 * k + 2], PA[4 * k + 3]); PB[4 + k] = (int)cvt4_bf8(PC[4 * k], PC[4 * k + 1], PC[4 * k + 2], PC[4 * k + 3]); \
        if constexpr (!FAST) sacc += ((PA[4 * k] + PA[4 * k + 1]) + (PA[4 * k + 2] + PA[4 * k + 3])) + ((PC[4 * k] + PC[4 * k + 1]) + (PC[4 * k + 2] + PC[4 * k + 3])); } } while (0)
    v8i vf[4], pa;
    ATT_SB();
#pragma unroll
    for (int d = 0; d < 4; ++d) vf[d] = ATT_LD8(vp + d * 2048);
    if constexpr (FAST) pa = st.pa; else ATT_PB(pa, st.p0, st.p1);
    ATT_SB();
    if constexpr (FAST) {
        ATT_MM8(st.o0, vf[0], pa); ATT_SB(); vf[0] = ATT_LD8(vp + 8192);
#pragma unroll
        for (int r = 0; r < 8; ++r) st.p2[r] = __builtin_amdgcn_exp2f(st.p2[r]);
        ATT_SB();
        ATT_MM8(st.o1, vf[1], pa); ATT_SB(); vf[1] = ATT_LD8(vp + 8192 + 2048);
#pragma unroll
        for (int r = 8; r < 16; ++r) st.p2[r] = __builtin_amdgcn_exp2f(st.p2[r]);
        ATT_SB();
        ATT_MM8(st.o2, vf[2], pa); ATT_SB(); vf[2] = ATT_LD8(vp + 8192 + 2 * 2048);
#pragma unroll
        for (int r = 0; r < 8; ++r) st.p3[r] = __builtin_amdgcn_exp2f(st.p3[r]);
        ATT_SB();
        ATT_MM8(st.o3, vf[3], pa); ATT_SB(); vf[3] = ATT_LD8(vp + 8192 + 3 * 2048);
#pragma unroll
        for (int r = 8; r < 16; ++r) st.p3[r] = __builtin_amdgcn_exp2f(st.p3[r]);
        ATT_SB();
        ATT_MM8(st.lacc, ones8, pa); ATT_SB();
        { v8i pb; ATT_PB(pb, st.p2, st.p3); pa = pb; }
        kf[0] = ATT_LD8(kpn); kf[1] = ATT_LD8(kpn + 2048);
        ATT_SB();
    } else {
    ATT_MM8(st.o0, vf[0], pa); ATT_MM8(st.o1, vf[1], pa); ATT_MM8(st.o2, vf[2], pa); ATT_MM8(st.o3, vf[3], pa);
    ATT_SB();
#pragma unroll
    for (int d = 0; d < 4; ++d) vf[d] = ATT_LD8(vp + 8192 + d * 2048);
    ATT_PB(pa, st.p2, st.p3);
    kf[0] = ATT_LD8(kpn); kf[1] = ATT_LD8(kpn + 2048);
    ATT_SB();
    }
    ATT_MM8(st.o0, vf[0], pa); ATT_MM8(st.o1, vf[1], pa); ATT_MM8(st.o2, vf[2], pa); ATT_MM8(st.o3, vf[3], pa);
    if constexpr (FAST) ATT_MM8(st.lacc, ones8, pa);
    kf[2] = ATT_LD8(kpn + 8192); kf[3] = ATT_LD8(kpn + 8192 + 2048);
    asm volatile("s_nop 15\n\ts_nop 7" ::: "memory");
    ATT_SB();
    if constexpr (!FAST) st.l_reg += sacc;
#undef ATT_MM8
#undef ATT_PB
}

constexpr int BG_ITEMS = NE * (32 * 64 + 32 * 32);
constexpr int BG_LDS = NSLOT * 2 * SLOTB;
struct BgCtx { const float* wgu; const float* wdn; unsigned char* tgu; unsigned char* tdn; };
struct BgItem { const float* src; unsigned char* dst; int N; };
__device__ __forceinline__ bool bg_decode(const BgCtx& c, int g, BgItem& it) {
    if (g >= BG_ITEMS) return false;
    const int e = g / 3072; int r = g % 3072;
    if (r < 2048) { const int nb = r >> 5, kb = r & 31; it.N = 2 * DFF; it.src = c.wgu + (size_t)e * D * 2 * DFF + (size_t)(32 * kb) * (2 * DFF) + 32 * nb; it.dst = c.tgu + (size_t)e * 2 * DFF * D + (size_t)(32 * nb) * D + 32 * kb; }
    else { r -= 2048; const int nb = r >> 5, kb = r & 31; it.N = D; it.src = c.wdn + (size_t)e * DFF * D + (size_t)(32 * kb) * D + 32 * nb; it.dst = c.tdn + (size_t)e * D * DFF + (size_t)(32 * nb) * DFF + 32 * kb; }
    return true;
}
__device__ __forceinline__ void bg_issue(const BgItem& it, unsigned lds_dst, int lane) { unsigned keep;
    const char* p0 = (const char*)(it.src + (size_t)(lane >> 3) * it.N + (lane & 7) * 4);
    const size_t rs = (size_t)8 * it.N * 4;
    const char* p1 = p0 + rs - 1024; const char* p2 = p0 + 2 * rs - 2048; const char* p3 = p0 + 3 * rs - 3072;
    asm volatile("s_mov_b32 %0, m0\n\ts_mov_b32 m0, %5\n\ts_nop 0\n\tglobal_load_lds_dwordx4 %1, off\n\tglobal_load_lds_dwordx4 %2, off offset:1024\n\tglobal_load_lds_dwordx4 %3, off offset:2048\n\tglobal_load_lds_dwordx4 %4, off offset:3072\n\ts_mov_b32 m0, %0"
                 : "=&s"(keep) : "v"(p0), "v"(p1), "v"(p2), "v"(p3), "s"(lds_dst) : "memory"); }
__device__ __forceinline__ void bg_convert(const BgItem& it, LAS const float* sc, int lane) {
    asm volatile("s_waitcnt vmcnt(0)" ::: "memory");
    const int n = lane & 31, kh = lane >> 5; float v[16];
#pragma unroll
    for (int i = 0; i < 16; ++i) v[i] = sc[(16 * kh + i) * 32 + n] * FP8_W_MUL;
    u32x4 a;
    a.x = cvt4_fp8(v[0], v[1], v[2], v[3]); a.y = cvt4_fp8(v[4], v[5], v[6], v[7]); a.z = cvt4_fp8(v[8], v[9], v[10], v[11]); a.w = cvt4_fp8(v[12], v[13], v[14], v[15]);
    *(u32x4*)(it.dst + (size_t)n * 1024 + 16 * kh) = a;
}
#define ATT_CLOSE(C) do { if ((C) == 8) { ATT_WAIT_BAR(8); } else if ((C) == 6) { ATT_WAIT_BAR(6); } else if ((C) == 5) { ATT_WAIT_BAR(5); } else if ((C) == 4) { ATT_WAIT_BAR(4); } else if ((C) == 3) { ATT_WAIT_BAR(3); } else { ATT_WAIT_BAR(2); } } while (0)

template <int THRL, bool FAST>
__device__ __forceinline__ void attn_unit(int b, int h, int qb, const bf16_t* proj, const bf16_t* kt, const bf16_t* vt, const unsigned char* q8g, bf16_t* oproj, char* shm, float lam, const float* __restrict__ subw, const BgCtx bg, int bgbase, int bgstride, const unsigned* kmax2_bits, int wid_in) {
    const int wid = __builtin_amdgcn_readfirstlane(wid_in), lane = lane_opaque(), r32 = lane & 31, hi = lane >> 5;
    const int qg = wid & 3, comp = wid >> 2;
    const long rowbase = (long)b * SEQ; const int q0 = qb * 128;
    const unsigned lds0 = (unsigned)(uintptr_t)shm;
    const lds_cptr shm3 = (lds_cptr)shm;
    LAS float* wsf = (LAS float*)(shm3 + WSF_OFF) + wid * 64;
    const bf16_t* ksrc = kt + (size_t)((b * 8 + h) * NTB) * 8192 + wid * 512 + lane * 8;
    const bf16_t* vsrc = vt + (size_t)((b * 8 + h) * NTB) * 8192 + wid * 512 + lane * 8;
    const unsigned kdst = lds0 + LDS_K + wid * 1024, vdst = lds0 + LDS_V + wid * 1024;
#define DMA_K(t, slot) do { const bf16_t* _s = ksrc + (size_t)(t) * 8192; glds16(_s, (unsigned)__builtin_amdgcn_readfirstlane(kdst + (slot))); glds16(_s + 4096, (unsigned)__builtin_amdgcn_readfirstlane(kdst + (slot) + 8192)); } while (0)
#define DMA_V(t, slot) do { const bf16_t* _s = vsrc + (size_t)(t) * 8192; glds16(_s, (unsigned)__builtin_amdgcn_readfirstlane(vdst + (slot))); glds16(_s + 4096, (unsigned)__builtin_amdgcn_readfirstlane(vdst + (slot) + 8192)); } while (0)
#define DMA_K16(t, slot) do { const bf16_t* _s = kt + (size_t)((b * 8 + h) * NTB + (t)) * 8192 + qg * 2048 + lane * 8; const unsigned _d = lds0 + LDS_K + (slot) + qg * 4096; \
        glds16x4(_s, (unsigned)__builtin_amdgcn_readfirstlane(_d)); } while (0)
#define DMA_V16(t, slot) do { const bf16_t* _s = vt + (size_t)((b * 8 + h) * NTB + (t)) * 8192 + qg * 2048 + lane * 8; const unsigned _d = lds0 + LDS_V + (slot) + qg * 4096; \
        glds16x4(_s, (unsigned)__builtin_amdgcn_readfirstlane(_d)); } while (0)
    const lds_cptr kp0 = shm3 + LDS_K + comp * 4096 + hi * 1024 + r32 * 32;
    const lds_cptr vp0 = shm3 + LDS_V + hi * 1024 + r32 * 32;
    DMA_K(0, 0); DMA_V(0, 0); DMA_K(1, SLOTB); DMA_V(1, SLOTB);
    v8i qr;
    { const unsigned char* qp = q8g + (size_t)(rowbase + q0 + qg * 32 + r32) * D + h * 128 + comp * 64 + 32 * hi;
      qr = __builtin_shufflevector(*(const v4i*)qp, *(const v4i*)(qp + 16), 0, 1, 2, 3, 4, 5, 6, 7); }
    AttnState st;
    st.o0 = f32x16{}; st.o1 = f32x16{}; st.o2 = f32x16{}; st.o3 = f32x16{};
    st.negm = f32x16{}; st.p0 = f32x16{}; st.p1 = f32x16{}; st.p2 = f32x16{}; st.p3 = f32x16{}; st.lacc = f32x16{}; st.mhat = 0.f; st.l_reg = 0.f;
    int sm1 = 2 * SLOTB, s0 = 0, sp1 = SLOTB;
#define ATT_ROT() do { const int _s = sm1; sm1 = s0; s0 = sp1; sp1 = _s; } while (0)
    v8i kf[4];
    const int grp = 4;
    BgItem bgi; bool bgp = false; const unsigned bgl = lds0 + BG_LDS + wid * 4096; LAS const float* bgs = (LAS const float*)(shm3 + BG_LDS + wid * 4096);
#define ATT_BG(t, CLOSE) do { CLOSE = grp; if (((t) & 3) == 1 && bgp) { bg_convert(bgi, bgs, lane); bgp = false; CLOSE = grp + 1; } } while (0)
#define ATT_BG_ISSUE(t, CLOSE) do { if (((t) & 3) == 0) { bgp = bg_decode(bg, bgbase + ((((t) >> 2) - 1) * 8 + wid) * bgstride, bgi); if (bgp) { bg_issue(bgi, (unsigned)__builtin_amdgcn_readfirstlane(bgl), lane); CLOSE = grp + 4; } } } while (0)
    if (comp == 0) {
        ATT_WAIT_BAR(0);
        attn_kload(kf, kp0 + s0);
        attn_s1<THRL, FAST>(st, kf, qr, true, r32, hi);
        DMA_K16(2, sm1);
        ATT_WAIT_BAR(4);
        attn_s2<FAST>(st, vp0 + s0, kf, kp0 + sp1);
        ATT_ROT();
#pragma unroll 1
        for (int t = 1; t < NTB; ++t) {
            const int tn = (t + 2 < NTB) ? t + 2 : NTB - 1; int cl;
            ATT_WAIT_BAR(8);
            attn_s1<THRL, FAST>(st, kf, qr, false, r32, hi);
            ATT_BG(t, cl);
            DMA_K16(tn, sm1);
            ATT_BG_ISSUE(t, cl);
            ATT_CLOSE(cl);
            attn_s2<FAST>(st, vp0 + s0, kf, kp0 + sp1);
            ATT_ROT();
        }
        ATT_WAIT_BAR(4);
    } else {
        ATT_WAIT_BAR(0);
        ATT_WAIT_BAR(8);
        attn_kload(kf, kp0 + s0);
        attn_s1<THRL, FAST>(st, kf, qr, true, r32, hi);
        DMA_V16(2, sm1);
        ATT_ROT();
        int cl = 4;
#pragma unroll 1
        for (int t = 1; t < NTB; ++t) {
            const int tn = (t + 2 < NTB) ? t + 2 : NTB - 1;
            ATT_CLOSE(cl);
            attn_s2<FAST>(st, vp0 + sm1, kf, kp0 + s0);
            ATT_WAIT_BAR(8);
            attn_s1<THRL, FAST>(st, kf, qr, false, r32, hi);
            ATT_BG(t, cl);
            DMA_V16(tn, sm1);
            ATT_BG_ISSUE(t, cl);
            ATT_ROT();
        }
        ATT_CLOSE(cl);
        attn_s2<FAST>(st, vp0 + sm1, kf, kp0 + s0);
    }
#undef ATT_BG
#undef ATT_BG_ISSUE
#undef ATT_ROT
    float l_reg = st.l_reg;
    if constexpr (FAST) { asm volatile("s_nop 15\n\ts_nop 15" ::: "memory"); l_reg = st.lacc[0]; }
    else { auto rr = __builtin_amdgcn_permlane32_swap(__float_as_uint(l_reg), __float_as_uint(l_reg), false, false); l_reg = __uint_as_float(rr[0]) + __uint_as_float(rr[1]); }
    const float coef = (comp == 0 ? 1.0f : -lam) / l_reg;
    ATT_WAIT_BAR(0);
    LAS float* X = (LAS float*)shm3;
    LAS float* Y = X + 4 * 2 * 32 * 64;
    f32x16 m0, m1;
    { LAS float* xw = X + ((qg * 2 + comp) * 32) * 64 + lane;
      if (comp == 0) {
#pragma unroll
          for (int r = 0; r < 16; ++r) { xw[r * 64] = st.o2[r] * coef; xw[(16 + r) * 64] = st.o3[r] * coef; }
          m0 = st.o0 * coef; m1 = st.o1 * coef;
      } else {
#pragma unroll
          for (int r = 0; r < 16; ++r) { xw[r * 64] = st.o0[r] * coef; xw[(16 + r) * 64] = st.o1[r] * coef; }
          m0 = st.o2 * coef; m1 = st.o3 * coef;
      } }
    ATT_WAIT_BAR(0);
    float ss = 0.f;
    { const LAS float* xr = X + ((qg * 2 + (1 - comp)) * 32) * 64 + lane;
#pragma unroll
      for (int r = 0; r < 16; ++r) { m0[r] += xr[r * 64]; m1[r] += xr[(16 + r) * 64]; ss += m0[r] * m0[r] + m1[r] * m1[r]; } }
    { auto rr = __builtin_amdgcn_permlane32_swap(__float_as_uint(ss), __float_as_uint(ss), false, false); ss = __uint_as_float(rr[0]) + __uint_as_float(rr[1]); }
    Y[(qg * 2 + comp) * 64 + lane] = ss;
    ATT_WAIT_BAR(0);
    ss += Y[(qg * 2 + (1 - comp)) * 64 + lane];
    { const float rstd = (1.0f - LAMBDA_INIT) / sqrtf(ss * (1.0f / 128.0f) + SUBLN_EPS);
      bf16_t* op = oproj + (rowbase + q0 + qg * 32 + r32) * D + h * 128 + 64 * comp + 4 * hi;
      const float* sw = subw + 64 * comp + 4 * hi;
#pragma unroll
      for (int g4 = 0; g4 < 4; ++g4) { const f32x4 w0 = *(const f32x4*)(sw + 8 * g4), w1 = *(const f32x4*)(sw + 32 + 8 * g4);
          u32x2 a, c2;
          a.x = cvt_pk_bf16(m0[4 * g4] * rstd * w0[0], m0[4 * g4 + 1] * rstd * w0[1]); a.y = cvt_pk_bf16(m0[4 * g4 + 2] * rstd * w0[2], m0[4 * g4 + 3] * rstd * w0[3]);
          c2.x = cvt_pk_bf16(m1[4 * g4] * rstd * w1[0], m1[4 * g4 + 1] * rstd * w1[1]); c2.y = cvt_pk_bf16(m1[4 * g4 + 2] * rstd * w1[2], m1[4 * g4 + 3] * rstd * w1[3]);
          *(u32x2*)(op + 8 * g4) = a; *(u32x2*)(op + 32 + 8 * g4) = c2; } }
    ATT_WAIT_BAR(0);
#undef DMA_K
#undef DMA_V
#undef DMA_K16
#undef DMA_V16
}
}

#define XB_TMO      128
#define XB_XCNT(j)  (256  + 64 * (j))
#define XB_XSUB(j)  (1280 + 64 * (j))
#define XB_XGEN(j)  (2304 + 64 * (j))
#define XB_TOP      3328
#define XB_TOPGEN   3392
#define XCD_BAR_WORDS 3456
#define XB_SPIN_CAP (1u << 18)
__device__ __forceinline__ unsigned xb_ld(unsigned* p)              { return __hip_atomic_load(p, __ATOMIC_RELAXED, __HIP_MEMORY_SCOPE_AGENT); }
__device__ __forceinline__ unsigned xb_add(unsigned* p, unsigned v) { return __hip_atomic_fetch_add(p, v, __ATOMIC_RELAXED, __HIP_MEMORY_SCOPE_AGENT); }
__device__ __forceinline__ unsigned xb_xcc_id() { return (unsigned)__builtin_amdgcn_s_getreg((3 << 11) | 20) & 0xFu; }
#define XB_SPIN(cond, bar) do { unsigned _sp = 0; while (cond) { __builtin_amdgcn_s_sleep(1); \
    if ((++_sp & 255u) == 0u) { if (xb_ld(&(bar)[XB_TMO])) break; if (_sp > XB_SPIN_CAP) { atomicAdd(&(bar)[XB_TMO], 1u); break; } } } } while (0)
struct XcdBarrier { unsigned* bar; unsigned x; volatile LAS unsigned* st; int wave; };
__device__ __forceinline__ XcdBarrier xcd_barrier_post(unsigned* bar, volatile LAS unsigned* st) {
    XcdBarrier b; b.bar = bar; b.x = xb_xcc_id(); b.st = st; b.wave = 0;
    if (threadIdx.x == 0) (void)xb_add(&bar[XB_XCNT(b.x)], 1u);
    return b;
}
__device__ __forceinline__ void xcd_barrier_complete(unsigned* bar, unsigned x, unsigned& nloc, unsigned& nx) {
    const unsigned G = gridDim.x * gridDim.y * gridDim.z;
    unsigned sum, cnt, mine, sp = 0u;
    for (;;) {
        sum = 0u; cnt = 0u; mine = 0u;
#pragma unroll
        for (unsigned j = 0; j < 16; ++j) { const unsigned c = xb_ld(&bar[XB_XCNT(j)]); sum += c; cnt += (c > 0u) ? 1u : 0u; mine = (j == x) ? c : mine; }
        if (sum == G) break;
        __builtin_amdgcn_s_sleep(1);
        if ((++sp & 255u) == 0u) { if (xb_ld(&bar[XB_TMO])) break; if (sp > XB_SPIN_CAP) { atomicAdd(&bar[XB_TMO], 1u); break; } }
    }
    nloc = mine > 0u ? mine : 1u; nx = cnt > 0u ? cnt : 1u;
}
__device__ __forceinline__ void xcd_barrier(const XcdBarrier& b) {
    asm volatile("s_waitcnt vmcnt(0)" ::: "memory");
    __syncthreads();
    if (b.wave == 0 && lane_opaque() == 0) {
        unsigned* bar = b.bar;
        __builtin_amdgcn_s_waitcnt(0);
        unsigned nloc = b.st[0], nx = b.st[1];
        if (nloc == 0u) { xcd_barrier_complete(bar, b.x, nloc, nx); b.st[0] = nloc; b.st[1] = nx; }
        const unsigned old = xb_add(&bar[XB_XSUB(b.x)], 1u);
        const unsigned gen = old / nloc;
        if (old + 1u == (gen + 1u) * nloc) {
            __builtin_amdgcn_fence(__ATOMIC_RELEASE, "agent");
            asm volatile("s_waitcnt vmcnt(0)" ::: "memory");
            const unsigned og = xb_add(&bar[XB_TOP], 1u);
            const unsigned tg = og / nx;
            if (og + 1u == (tg + 1u) * nx) xb_add(&bar[XB_TOPGEN], 1u);
            else XB_SPIN(xb_ld(&bar[XB_TOPGEN]) == tg, bar);
            __builtin_amdgcn_fence(__ATOMIC_ACQUIRE, "agent");
            xb_add(&bar[XB_XGEN(b.x)], 1u);
            asm volatile("s_waitcnt vmcnt(0)" ::: "memory");
        } else {
            XB_SPIN(xb_ld(&bar[XB_XGEN(b.x)]) == gen, bar);
            __builtin_amdgcn_fence(__ATOMIC_ACQUIRE, "agent");
            asm volatile("s_waitcnt vmcnt(0)" ::: "memory");
        }
    }
    __syncthreads();
}

constexpr int NWAVES = 8;
constexpr int N_PHASES = 11;
struct Frame {
    LAS unsigned char* lds;
    volatile LAS unsigned* MISC;
    gu32* ctl;
    int tid, lane, wave, vcu, G;
    unsigned char* ws;
    const float *x, *c, *w_ada, *b_ada, *norm1_w, *w_in, *q_norm_w, *k_norm_w, *lq1, *lk1, *lq2, *lk2, *subln_w, *w_attn_o, *conv_w, *w_conv_o, *w_out, *norm2_w,
                *w_router, *b_router, *w_gate_up, *b_gate_up, *w_down, *b_down;
    float* out;
};

__device__ __forceinline__ void p0_transpose_item(const float* W, int K, int N, bf16_t* WT, LAS float* scr, int item, int lane) {
    const int nblk = N / 32, kb = item / nblk, nb = item % nblk, k0 = 64 * kb, n0 = 32 * nb;
#pragma unroll 8
    for (int i = 0; i < 32; ++i) { const int kk = 2 * i + (lane >> 5); scr[kk * 33 + (lane & 31)] = W[(size_t)(k0 + kk) * N + n0 + (lane & 31)]; }
    LDS_WAIT(); asm volatile("" ::: "memory");
    const int c = lane & 7;
#pragma unroll
    for (int j = 0; j < 4; ++j) { const int n = (lane >> 3) + 8 * j; const LAS float* s = scr + (8 * c) * 33 + n;
        u32x4 o; o.x = pk2(s[0 * 33], s[1 * 33]); o.y = pk2(s[2 * 33], s[3 * 33]); o.z = pk2(s[4 * 33], s[5 * 33]); o.w = pk2(s[6 * 33], s[7 * 33]);
        *(GAS u32x4*)(WT + (size_t)(n0 + n) * K + k0 + 8 * c) = o; }
    LDS_WAIT(); asm volatile("" ::: "memory");
}

__device__ __forceinline__ void p0_transpose_item8(const float* W, int K, int N, unsigned char* WT, int nrow0, LAS float* scr, int item, int lane) {
    const int nblk = N / 32, kb = item / nblk, nb = item % nblk, k0 = 64 * kb, n0 = 32 * nb;
#pragma unroll 8
    for (int i = 0; i < 32; ++i) { const int kk = 2 * i + (lane >> 5); scr[kk * 33 + (lane & 31)] = W[(size_t)(k0 + kk) * N + n0 + (lane & 31)]; }
    LDS_WAIT(); asm volatile("" ::: "memory");
    const int c = lane & 7;
#pragma unroll
    for (int j = 0; j < 4; ++j) { const int n = (lane >> 3) + 8 * j; const LAS float* s = scr + (8 * c) * 33 + n;
        u32x2 o; o.x = cvt4_fp8(s[0 * 33] * FP8_W_MUL, s[1 * 33] * FP8_W_MUL, s[2 * 33] * FP8_W_MUL, s[3 * 33] * FP8_W_MUL); o.y = cvt4_fp8(s[4 * 33] * FP8_W_MUL, s[5 * 33] * FP8_W_MUL, s[6 * 33] * FP8_W_MUL, s[7 * 33] * FP8_W_MUL);
        *(GAS u32x2*)(WT + (size_t)(nrow0 + n0 + n) * K + k0 + 8 * c) = o; }
    LDS_WAIT(); asm volatile("" ::: "memory");
}
__device__ __forceinline__ void phase_p0(Frame& F) {
    LAS float* scr = (LAS float*)(F.lds + F.wave * 16384);
    const int gw = F.vcu * NWAVES + F.wave, NGW = F.G * NWAVES;
    for (int it = gw; it < 96 * 16; it += NGW) {
        const int cg = it % 96, ks = it / 96, col = cg * 64 + F.lane;
        float a0 = 0.f, a1 = 0.f;
#pragma unroll 8
        for (int kk = 0; kk < 64; ++kk) { const int k = ks * 64 + kk; const float w = F.w_ada[(size_t)k * 6144 + col];
            const float c0 = F.c[k], c1 = F.c[D + k];
            a0 += (c0 * sigmoidf_fast(c0)) * w; a1 += (c1 * sigmoidf_fast(c1)) * w; }
        float* mp = (float*)(F.ws + WS_MODP);
        mp[(size_t)(ks * 2 + 0) * 6144 + col] = a0; mp[(size_t)(ks * 2 + 1) * 6144 + col] = a1;
    }
    { f32x2* cs = (f32x2*)(F.ws + WS_ROPE); const int gt = F.vcu * 512 + F.tid, NGT = F.G * 512;
      for (int idx = gt; idx < SEQ * 32; idx += NGT) { const int pos = idx >> 5, i = idx & 31;
          const float invf = exp2f(-(float)i * (13.287712379549449f / 32.0f));
          const float ang = (float)pos * invf;
          const double rev = (double)ang * 0.15915494309189535; const double fr = rev - floor(rev);
          const float frf = (float)fr;
          cs[idx] = (f32x2){__builtin_amdgcn_cosf(frf), __builtin_amdgcn_sinf(frf)}; } }
    constexpr int I_IN = (D / 64) * (INW / 32), I_SQ = (D / 64) * (D / 32), I_GU = (D / 64) * (2 * DFF / 32), I_DN = (DFF / 64) * (D / 32);
    constexpr int NITEMS = I_IN + 3 * I_SQ;
    for (int it = gw; it < NITEMS; it += NGW) {
        int r = it;
        if (r < I_IN) { const int nb = r % (INW / 32), n0 = 32 * nb;
            if (n0 >= C_CB && n0 < C_GA) p0_transpose_item(F.w_in, D, INW, (bf16_t*)(F.ws + WS_WIN) - (size_t)C_CB * D, scr, r, F.lane);
            else { const int dst = n0 < C_V ? 256 * (n0 >> 8) + 128 * ((n0 >> 5) & 1) + 32 * ((n0 >> 6) & 3)
                                           : (n0 < C_CB ? n0 : n0 - (C_GA - C_CB));
                p0_transpose_item8(F.w_in, D, INW, F.ws + WS_WIN + 8 * MiB, dst - n0, scr, r, F.lane); }
            continue; } r -= I_IN;
        if (r < I_SQ) { p0_transpose_item(F.w_attn_o, D, D, (bf16_t*)(F.ws + WS_WAO), scr, r, F.lane); continue; } r -= I_SQ;
        if (r < I_SQ) { p0_transpose_item(F.w_conv_o, D, D, (bf16_t*)(F.ws + WS_WCO), scr, r, F.lane); continue; } r -= I_SQ;
        if (r < I_SQ) { p0_transpose_item(F.w_out, D, D, (bf16_t*)(F.ws + WS_WOUT), scr, r, F.lane); continue; } r -= I_SQ;
        if (r < NE * I_GU) { const int e = r / I_GU, ii = r % I_GU;
            p0_transpose_item(F.w_gate_up + (size_t)e * D * 2 * DFF, D, 2 * DFF, (bf16_t*)(F.ws + WS_WGU) + (size_t)e * 2 * DFF * D, scr, ii, F.lane); continue; } r -= NE * I_GU;
        { const int e = r / I_DN, ii = r % I_DN;
            p0_transpose_item(F.w_down + (size_t)e * DFF * D, DFF, D, (bf16_t*)(F.ws + WS_WD) + (size_t)e * D * DFF, scr, ii, F.lane); }
    }
}

__device__ __forceinline__ void phase_p1(Frame& F) {
    const float* mp = (const float*)(F.ws + WS_MODP);
    const int v = F.vcu, b = v >> 7;
    LAS float* a1 = (LAS float*)F.lds; LAS float* s1 = a1 + D;
    for (int col = F.tid; col < D; col += 512) {
        float sh = F.b_ada[col], sc = F.b_ada[D + col];
#pragma unroll
        for (int ks = 0; ks < 16; ++ks) { sh += mp[(size_t)(ks * 2 + b) * 6144 + col]; sc += mp[(size_t)(ks * 2 + b) * 6144 + D + col]; }
        a1[col] = F.norm1_w[col] * (1.0f + sc); s1[col] = sh;
    }
    if (F.tid < 48) { const int f = 48 * v + F.tid, bb = f / 6144, cc = f % 6144; float m = F.b_ada[cc];
#pragma unroll
        for (int ks = 0; ks < 16; ++ks) m += mp[(size_t)(ks * 2 + bb) * 6144 + cc];
        ((float*)(F.ws + WS_MOD))[f] = m; }
    __syncthreads();
    f32x4 av[4], sv[4];
#pragma unroll
    for (int j = 0; j < 4; ++j) { av[j] = *(const LAS f32x4*)(a1 + 4 * F.lane + 256 * j); sv[j] = *(const LAS f32x4*)(s1 + 4 * F.lane + 256 * j); }
    bf16_t* XN = (bf16_t*)(F.ws + WS_XN);
#pragma unroll 4
    for (int i = 0; i < 8; ++i) { const int row = 64 * v + 8 * F.wave + i;
        const GAS f32x4* xr = (const GAS f32x4*)(F.x + (size_t)row * D) + F.lane;
        f32x4 xv[4]; float s = 0.f;
#pragma unroll
        for (int j = 0; j < 4; ++j) { xv[j] = xr[64 * j]; s += (xv[j].x * xv[j].x + xv[j].y * xv[j].y) + (xv[j].z * xv[j].z + xv[j].w * xv[j].w); }
        const float rstd = 1.0f / sqrtf(wave_sum(s) * (1.0f / D) + RMS_EPS);
        GAS unsigned long long* o8 = (GAS unsigned long long*)(XN + (size_t)row * D) + F.lane;
        GAS unsigned* o4 = (GAS unsigned*)(F.ws + WS_XN8 + (size_t)row * D) + F.lane;
#pragma unroll
        for (int j = 0; j < 4; ++j) { const f32x4 hh = xv[j] * rstd * av[j] + sv[j];
            o8[64 * j] = (unsigned long long)pk2(hh.x, hh.y) | ((unsigned long long)pk2(hh.z, hh.w) << 32);
            o4[64 * j] = cvt4_fp8(hh.x, hh.y, hh.z, hh.w); } }
    __syncthreads();
}

__device__ __forceinline__ void conv_loadu(const bf16_t* proj, int row, int c0, float (&u)[8]) {
    const u32x4 a = *(const u32x4*)(proj + PL(C_CC) + (size_t)row * D + c0), c = *(const u32x4*)(proj + PL(C_CX) + (size_t)row * D + c0);
    u[0] = bflo(a.x) * bflo(c.x); u[1] = bfhi(a.x) * bfhi(c.x); u[2] = bflo(a.y) * bflo(c.y); u[3] = bfhi(a.y) * bfhi(c.y);
    u[4] = bflo(a.z) * bflo(c.z); u[5] = bfhi(a.z) * bfhi(c.z); u[6] = bflo(a.w) * bflo(c.w); u[7] = bfhi(a.w) * bfhi(c.w);
}
__device__ __forceinline__ void phase_l1(Frame& F) {
    bf16_t* proj = (bf16_t*)(F.ws + WS_PROJ);
    const f32x2* cs = (const f32x2*)(F.ws + WS_ROPE);
    const int lane = F.lane, sub = lane & 3, grp = lane >> 2;
    const int r0 = 64 * F.vcu + 8 * F.wave;
#pragma unroll 1
    for (int ch = 0; ch < 2; ++ch) { const int c0 = 512 * ch + 8 * lane;
        float w0[8], w1[8], w2[8];
#pragma unroll
        for (int j = 0; j < 8; ++j) { w0[j] = F.conv_w[c0 + j]; w1[j] = F.conv_w[D + c0 + j]; w2[j] = F.conv_w[2 * D + c0 + j]; }
        u32x4 av[10], cv[10], bv8[8];
#pragma unroll
        for (int q = 0; q < 10; ++q) { const int row = r0 - 1 + q; const bool ok = (q == 0) ? ((r0 & (SEQ - 1)) != 0) : (q == 9 ? (((r0 + 8) & (SEQ - 1)) != 0) : true);
            const int rr = ok ? row : r0;
            av[q] = *(const u32x4*)(proj + PL(C_CC) + (size_t)rr * D + c0); cv[q] = *(const u32x4*)(proj + PL(C_CX) + (size_t)rr * D + c0);
            if (!ok) { av[q] = (u32x4){0u, 0u, 0u, 0u}; } }
#pragma unroll
        for (int q = 0; q < 8; ++q) bv8[q] = *(const u32x4*)(proj + PL(C_CB) + (size_t)(r0 + q) * D + c0);
        __builtin_amdgcn_sched_barrier(0);
        float up[8], uc[8], un[8];
#define CONV_U(dst, q) do { const u32x4 a_ = av[q], c_ = cv[q]; dst[0] = bflo(a_.x) * bflo(c_.x); dst[1] = bfhi(a_.x) * bfhi(c_.x); dst[2] = bflo(a_.y) * bflo(c_.y); dst[3] = bfhi(a_.y) * bfhi(c_.y); \
        dst[4] = bflo(a_.z) * bflo(c_.z); dst[5] = bfhi(a_.z) * bfhi(c_.z); dst[6] = bflo(a_.w) * bflo(c_.w); dst[7] = bfhi(a_.w) * bfhi(c_.w); } while (0)
        CONV_U(up, 0); CONV_U(uc, 1);
#pragma unroll
        for (int i = 0; i < 8; ++i) { const int row = r0 + i;
            CONV_U(un, i + 2);
            const u32x4 bv = bv8[i];
            const float cbv[8] = {bflo(bv.x), bfhi(bv.x), bflo(bv.y), bfhi(bv.y), bflo(bv.z), bfhi(bv.z), bflo(bv.w), bfhi(bv.w)};
            float z[8];
#pragma unroll
            for (int j = 0; j < 8; ++j) { z[j] = cbv[j] * (w0[j] * up[j] + w1[j] * uc[j] + w2[j] * un[j]); up[j] = uc[j]; uc[j] = un[j]; }
            u32x4 w; w.x = pk2(z[0], z[1]); w.y = pk2(z[2], z[3]); w.z = pk2(z[4], z[5]); w.w = pk2(z[6], z[7]);
            *(u32x4*)((bf16_t*)(F.ws + WS_Z) + (size_t)row * D + c0) = w; }
#undef CONV_U
    }
}

struct InProjOrder {
    pg8::StaticOrder so;
    __device__ bool next(int i, pg8::Unit& u) const { return so.next(i, u); }
    __device__ __forceinline__ int arow(const pg8::Unit& u, int r) const {
        if (u.pn >= 8 && u.pn < 12) { const int ai = (r >> 7) & 1, wr = (r >> 6) & 1, m = (r >> 4) & 3, fr = r & 15;
            r = 64 * (2 * wr + (fr >> 3)) + 16 * ((fr >> 1) & 3) + 8 * ai + 4 * (fr & 1) + m; }
        return u.pm * pg8::BM + r; }
    __device__ __forceinline__ int acol(const pg8::Unit&) const { return 0; }
};
struct ChainOrder {
    pg8::StaticOrder so;
    __device__ bool next(int i, pg8::Unit& u) const { if (i >= 2) return false; const bool ok = so.next(0, u); u.e = 1 - i; return ok; }
    __device__ __forceinline__ int arow(const pg8::Unit& u, int r) const { return u.pm * pg8::BM + r; }
    __device__ __forceinline__ int acol(const pg8::Unit& u) const { return u.e ? 0 : (int)((WS_ON - WS_Z) / 2); }
};
__device__ __forceinline__ void moe_tables(Frame& F) {
    LAS int* tb = (LAS int*)(F.lds + TBL_OFF);
    if (F.wave == 0) {
        const int e = F.lane & 31; int c = (int)__hip_atomic_load(F.ctl + CW_CNT + e, RLX_AGENT); c = c > ECAP ? ECAP : c;
        const int nte = (c + 255) >> 8; int inc = nte;
#pragma unroll
        for (int o = 1; o < 32; o <<= 1) { const int v = __shfl_up(inc, o, 32); if (e >= o) inc += v; }
        const int base = inc - nte;
        if (F.lane < NE) { tb[e] = c; tb[32 + e] = base;
            for (int t = 0; t < nte; ++t) { if (base + t < MAXTILES) { tb[128 + base + t] = e; tb[448 + base + t] = 256 * t; } }
            if (e == NE - 1) { tb[64] = inc; tb[65] = inc > MAXTILES ? MAXTILES : inc; } } }
    __syncthreads();
}
struct MoeOrder {
    int nunits, npn, c; const LAS int* tb; const int* list; bool gather;
    __device__ bool next(int i, pg8::Unit& u) const {
        const int idx = (i * 8 + (c & 7)) * 32 + (c >> 3); if (idx >= nunits) return false;
        u.pm = idx / npn; u.pn = idx % npn; u.e = tb[128 + u.pm]; return true;
    }
    __device__ __forceinline__ int arow(const pg8::Unit& u, int r) const {
        if (!gather) return u.pm * 256 + r;
        const int jl = tb[448 + u.pm] + r; const int cnt = tb[u.e];
        return list[(size_t)u.e * ECAP + (jl < cnt ? jl : 0)];
    }
    __device__ __forceinline__ int acol(const pg8::Unit&) const { return 0; }
};

__device__ __forceinline__ void phase_r1(Frame& F) {
    const float* mod = (const float*)(F.ws + WS_MOD);
    const int v = F.vcu, b = v >> 7, lane = F.lane, w = F.wave;
    constexpr int TROW = 1028;
    LAS float* tile = (LAS float*)F.lds;
    LAS float* part = (LAS float*)F.lds;
    LAS float* lg = (LAS float*)(F.lds + 40960);
    LAS int* hist = (LAS int*)(F.lds + TBL_OFF);
    LAS int* sel = (LAS int*)(F.lds + TBL_OFF + 512);
    if (F.tid < 64) hist[F.tid] = 0;
    f32x4 av[4], sv[4];
#pragma unroll
    for (int j = 0; j < 4; ++j) { const int col = 4 * lane + 256 * j;
        const f32x4 nw = *(const f32x4*)(F.norm2_w + col), sc = *(const f32x4*)(mod + b * 6144 + 4 * D + col);
        av[j] = nw * (1.0f + sc); sv[j] = *(const f32x4*)(mod + b * 6144 + 3 * D + col); }
    bf16_t* H2 = (bf16_t*)(F.ws + WS_XN);
    const float* x1 = F.out;
    float bwr[16][4];
#pragma unroll
    for (int j = 0; j < 16; ++j)
#pragma unroll
        for (int i = 0; i < 4; ++i) bwr[j][i] = F.w_router[(size_t)(128 * w + 8 * j + 4 * (lane >> 5) + i) * NE + (lane & 31)];
    for (int tl = 0; tl < 2; ++tl) {
        __syncthreads();
#pragma unroll
        for (int i = 0; i < 4; ++i) { const int lr = 4 * w + i, row = 64 * v + 32 * tl + lr;
            const GAS f32x4* xr = (const GAS f32x4*)(x1 + (size_t)row * D) + lane;
            f32x4 xv[4]; float s = 0.f;
#pragma unroll
            for (int j = 0; j < 4; ++j) { xv[j] = xr[64 * j]; s += (xv[j].x * xv[j].x + xv[j].y * xv[j].y) + (xv[j].z * xv[j].z + xv[j].w * xv[j].w); }
            const float rstd = 1.0f / sqrtf(wave_sum(s) * (1.0f / D) + RMS_EPS);
            GAS unsigned* o4 = (GAS unsigned*)((unsigned char*)H2 + (size_t)row * D) + lane;
#pragma unroll
            for (int j = 0; j < 4; ++j) { const f32x4 hh = xv[j] * rstd * av[j] + sv[j];
                o4[64 * j] = cvt4_fp8(hh.x, hh.y, hh.z, hh.w);
                *(LAS f32x4*)(tile + lr * TROW + 4 * lane + 256 * j) = hh; } }
        __syncthreads();
        f32x16 acc = f32x16{};
        { const int r32 = lane & 31, hi = lane >> 5;
#pragma unroll
          for (int j = 0; j < 16; ++j) { const int k0 = 128 * w + 8 * j + 4 * hi;
              const f32x4 a4 = *(const LAS f32x4*)(tile + r32 * TROW + k0);
#pragma unroll
              for (int i = 0; i < 4; ++i) acc = __builtin_amdgcn_mfma_f32_32x32x2f32(a4[i], bwr[j][i], acc, 0, 0, 0); }
          __syncthreads();
#pragma unroll
          for (int r = 0; r < 16; ++r) part[(w * 32 + attn::crow(r, hi)) * 33 + r32] = acc[r]; }
        __syncthreads();
        for (int idx = F.tid; idx < 1024; idx += 512) { const int row = idx >> 5, e = idx & 31; float s = F.b_router[e];
#pragma unroll
            for (int ww = 0; ww < 8; ++ww) s += part[(ww * 32 + row) * 33 + e];
            lg[row * 33 + e] = s; }
        __syncthreads();
        if (F.tid < 32) { const int row = F.tid; float lv[32];
#pragma unroll
            for (int e = 0; e < 32; ++e) lv[e] = lg[row * 33 + e];
            int se[4]; float svv[4];
#pragma unroll
            for (int k = 0; k < 4; ++k) { float best = -INFINITY; int bi = 0;
#pragma unroll
                for (int e = 0; e < 32; ++e) { const bool better = lv[e] > best; best = better ? lv[e] : best; bi = better ? e : bi; }
                se[k] = bi; svv[k] = best;
#pragma unroll
                for (int e = 0; e < 32; ++e) lv[e] = (e == bi) ? -INFINITY : lv[e]; }
            float ex[4], den = 0.f;
#pragma unroll
            for (int k = 0; k < 4; ++k) { ex[k] = __expf(svv[k] - svv[0]); den += ex[k]; }
#pragma unroll
            for (int k = 0; k < 4; ++k) { const int pos = __hip_atomic_fetch_add(&hist[se[k]], 1, __ATOMIC_RELAXED, __HIP_MEMORY_SCOPE_WORKGROUP); const int li = (32 * tl + row) * 4 + k;
                sel[li] = se[k]; sel[256 + li] = pos; sel[512 + li] = __float_as_int(ex[k] / den); } }
    }
    __syncthreads();
    if (F.tid < NE) { const int n = hist[F.tid]; hist[32 + F.tid] = n ? (int)__hip_atomic_fetch_add(F.ctl + CW_CNT + F.tid, (unsigned)n, RLX_AGENT) : 0; }
    __syncthreads();
    if (F.tid < 256) { const int li = F.tid, e = sel[li], idx = hist[32 + e] + sel[256 + li]; const int tok = 64 * v + (li >> 2);
        int* list = (int*)(F.ws + WS_LIST); int* pair = (int*)(F.ws + WS_PAIR); float* pw = (float*)(F.ws + WS_PAIR + 512 * 1024);
        if (idx < ECAP) list[(size_t)e * ECAP + idx] = tok;
        pair[tok * 4 + (li & 3)] = (e << 20) | idx; pw[tok * 4 + (li & 3)] = __int_as_float(sel[512 + li]); }
    __syncthreads();
}

__device__ __forceinline__ void phase_f(Frame& F) {
    const float* mod = (const float*)(F.ws + WS_MOD);
    const LAS int* tb = (const LAS int*)(F.lds + TBL_OFF);
    const int v = F.vcu, b = v >> 7, lane = F.lane;
    const int* pair = (const int*)(F.ws + WS_PAIR); const float* pw = (const float*)(F.ws + WS_PAIR + 512 * 1024);
    const bf16_t* Y = (const bf16_t*)(F.ws + WS_Y);
    f32x4 g2[4];
#pragma unroll
    for (int j = 0; j < 4; ++j) g2[j] = *(const f32x4*)(mod + b * 6144 + 5 * D + 4 * lane + 256 * j);
#pragma unroll 4
    for (int i = 0; i < 8; ++i) { const int row = 64 * v + 8 * F.wave + i;
        f32x4 acc[4], ov[4];
        GAS f32x4* orow = (GAS f32x4*)(F.out + (size_t)row * D) + lane;
#pragma unroll
        for (int j = 0; j < 4; ++j) { acc[j] = (f32x4){0.f, 0.f, 0.f, 0.f}; ov[j] = orow[64 * j]; }
#pragma unroll
        for (int k = 0; k < 4; ++k) { const int pr = pair[row * 4 + k]; const float wk = pw[row * 4 + k];
            const int e = pr >> 20, idx = pr & 0xfffff; const size_t slot = (size_t)tb[32 + e] * 256 + idx;
            const GAS u32x2* yr = (const GAS u32x2*)(Y + slot * D) + lane;
#pragma unroll
            for (int j = 0; j < 4; ++j) { const u32x2 yv = yr[64 * j];
                acc[j] += wk * (f32x4){bflo(yv.x), bfhi(yv.x), bflo(yv.y), bfhi(yv.y)}; } }
#pragma unroll
        for (int j = 0; j < 4; ++j) orow[64 * j] = ov[j] + g2[j] * acc[j]; }
}

struct Args { const float* in[24]; float* out; unsigned char* ws; int ph_lo, ph_hi; };
__global__ void __launch_bounds__(NWAVES * 64, 2) mk_fwd(Args args) {
    extern __shared__ __attribute__((aligned(16))) unsigned char lds[];
    Frame F;
    F.lds = (LAS unsigned char*)lds;
    F.MISC = (volatile LAS unsigned*)(F.lds + MISC_OFF);
    F.tid = threadIdx.x; F.lane = F.tid & 63; F.wave = __builtin_amdgcn_readfirstlane(F.tid >> 6);
    F.G = gridDim.x; { const int bx = blockIdx.x; F.vcu = (F.G % 8 == 0) ? (bx % 8) * (F.G / 8) + bx / 8 : bx; }
    F.ws = args.ws; F.ctl = (gu32*)(args.ws + WS_CTL); F.out = args.out;
    F.x = args.in[0]; F.c = args.in[1]; F.w_ada = args.in[2]; F.b_ada = args.in[3]; F.norm1_w = args.in[4]; F.w_in = args.in[5]; F.q_norm_w = args.in[6]; F.k_norm_w = args.in[7];
    F.lq1 = args.in[8]; F.lk1 = args.in[9]; F.lq2 = args.in[10]; F.lk2 = args.in[11]; F.subln_w = args.in[12]; F.w_attn_o = args.in[13]; F.conv_w = args.in[14]; F.w_conv_o = args.in[15];
    F.w_out = args.in[16]; F.norm2_w = args.in[17]; F.w_router = args.in[18]; F.b_router = args.in[19]; F.w_gate_up = args.in[20]; F.b_gate_up = args.in[21]; F.w_down = args.in[22]; F.b_down = args.in[23];
    for (int u = F.tid; u < (LDS_BYTES - MISC_OFF) / 4; u += NWAVES * 64) ((LAS unsigned*)(F.lds + MISC_OFF))[u] = 0u;
    __syncthreads();
    XcdBarrier bar; bar.bar = (unsigned*)(F.ctl + CW_BAR); bar.x = 0; bar.st = nullptr;
    if (!MK_PER_PHASE) bar = xcd_barrier_post((unsigned*)(F.ctl + CW_BAR), F.MISC + 8);
    bar.wave = F.wave;
#define GRID_BAR() do { if (!MK_PER_PHASE) xcd_barrier(bar); } while (0)
    const int lo = args.ph_lo, hi = args.ph_hi;
#define IN(k) ((lo <= (k) && (k) < hi) && (F.lane = lane_opaque(), F.tid = F.wave * 64 + F.lane, true))
#define BOTH(k) (IN(k) && IN((k) + 1))
    bf16_t* PROJ = (bf16_t*)(F.ws + WS_PROJ); bf16_t* XN = (bf16_t*)(F.ws + WS_XN); bf16_t* MM = (bf16_t*)(F.ws + WS_MM);
    bf16_t* ACT = (bf16_t*)(F.ws + WS_ACT); bf16_t* YB = (bf16_t*)(F.ws + WS_Y);

    if (IN(0)) { phase_p0(F); if (BOTH(0)) GRID_BAR(); }
    if (IN(1)) { phase_p1(F); if (BOTH(1)) GRID_BAR(); }
    if (IN(2)) {
        {   pg8::Gemm g{(const bf16_t*)(F.ws + WS_XN8), (const bf16_t*)(F.ws + WS_WIN + 8 * MiB), D / 2, D / 2, 0}; InProjOrder S; S.so.init(M, 5120, F.G, (int)blockIdx.x);
            pg8::EpiInProj E{pg8::EpiStore{PROJ, 0, nullptr, 0, 12, 0, C_GA}, F.q_norm_w, F.k_norm_w, (const f32x2*)(F.ws + WS_ROPE), F.ws + WS_Q8, F.ws + WS_KT, (unsigned*)(F.ctl + CW_KMAX), F.ws + WS_VT};
            pg8::gemm_phase<pg8::EpiInProj, InProjOrder, true, true>(F.lds, g, S, E, F.wave); }
        {   pg8::Gemm g{XN, (const bf16_t*)(F.ws + WS_WIN), D, D, 0}; pg8::StaticOrder S; S.init(M, 3072, F.G, (int)blockIdx.x);
            pg8::EpiStore E{PROJ, 0, nullptr, 0, 1 << 30, C_CB, 0};
            pg8::gemm_phase<pg8::EpiStore, pg8::StaticOrder, true, false>(F.lds, g, S, E, F.wave); }
        if (BOTH(2)) GRID_BAR();
    }
    if (IN(3)) { phase_l1(F); if (BOTH(3)) GRID_BAR(); }
    if (IN(4)) {
        {
            float lam;
            { const float a = F.lq1[F.lane] * F.lk1[F.lane], c2 = F.lq2[F.lane] * F.lk2[F.lane];
              lam = __expf(wave_sum(a)) - __expf(wave_sum(c2)) + LAMBDA_INIT; }
            const attn::BgCtx bgc{F.w_gate_up, F.w_down, F.ws + WS_WGU, F.ws + WS_WD};
            bool fastw;
            { const int gi = (F.vcu >> 4) * 2 + (F.wave >> 2); const float q2 = __uint_as_float(__hip_atomic_load(F.ctl + CW_KMAX + gi, RLX_AGENT)), k2 = __uint_as_float(__hip_atomic_load(F.ctl + CW_KMAX + 32 + gi, RLX_AGENT));
              fastw = __builtin_amdgcn_readfirstlane((sqrtf(q2 * k2) * 1.02f + 1e-3f < 15.0f) ? 1 : 0) != 0; }
            for (int i = 0; i < 4; ++i) { const int bh = F.vcu >> 4, qb = (F.vcu & 15) * 4 + i;
                if (F.G == 256) { if (fastw) attn::attn_unit<8, true>(bh >> 3, bh & 7, qb, PROJ, (const bf16_t*)(F.ws + WS_KT), (const bf16_t*)(F.ws + WS_VT), F.ws + WS_Q8, (bf16_t*)(F.ws + WS_ON), (char*)lds, lam, F.subln_w, bgc, (i * 15 * 8) * 256 + F.vcu, 256, (const unsigned*)(F.ctl + CW_KMAX), F.wave);
                                  else attn::attn_unit<8, false>(bh >> 3, bh & 7, qb, PROJ, (const bf16_t*)(F.ws + WS_KT), (const bf16_t*)(F.ws + WS_VT), F.ws + WS_Q8, (bf16_t*)(F.ws + WS_ON), (char*)lds, lam, F.subln_w, bgc, (i * 15 * 8) * 256 + F.vcu, 256, (const unsigned*)(F.ctl + CW_KMAX), F.wave); } }
        }
        if (BOTH(4)) GRID_BAR();
    }
    if (IN(5)) {
        pg8::Gemm g{(const bf16_t*)(F.ws + WS_Z), (const bf16_t*)(F.ws + WS_WAO), D, D, (size_t)D * D}; ChainOrder S; S.so.init(M, D, F.G, (int)blockIdx.x);
        pg8::EpiGateChain E{MM, PROJ + PL(C_GA), PROJ + PL(C_GC), D};
        pg8::gemm_phase<pg8::EpiGateChain, ChainOrder, false>(F.lds, g, S, E, F.wave);
        if (BOTH(5)) GRID_BAR();
    }
    if (IN(6)) {
        pg8::Gemm g{MM, (const bf16_t*)(F.ws + WS_WOUT), D, D, 0}; pg8::StaticOrder S; S.init(M, D, F.G, (int)blockIdx.x);
        pg8::EpiResid E{F.x, F.out, (const float*)(F.ws + WS_MOD) + 2 * D};
        pg8::gemm_phase<pg8::EpiResid, pg8::StaticOrder, false>(F.lds, g, S, E, F.wave);
        if (BOTH(6)) GRID_BAR();
    }
    if (IN(7)) { phase_r1(F); if (BOTH(7)) GRID_BAR(); }
    if (IN(8)) {
        moe_tables(F);
        const LAS int* tb = (const LAS int*)(F.lds + TBL_OFF);
        pg8::Gemm g{XN, (const bf16_t*)(F.ws + WS_WGU), D / 2, D / 2, (size_t)2 * DFF * D / 2};
        MoeOrder S{tb[65] * 8, 8, (int)blockIdx.x, tb, (const int*)(F.ws + WS_LIST), true};
        pg8::EpiSwiglu E{(unsigned char*)ACT, F.b_gate_up};
        for (int rep = 0; rep < PROBE_REP_MOE; ++rep) pg8::gemm_phase<pg8::EpiSwiglu, MoeOrder, true, true>(F.lds, g, S, E, F.wave);
        if (BOTH(8)) GRID_BAR();
    }
    if (IN(9)) {
        moe_tables(F);
        const LAS int* tb = (const LAS int*)(F.lds + TBL_OFF);
        pg8::Gemm g{ACT, (const bf16_t*)(F.ws + WS_WD), DFF / 2, DFF / 2, (size_t)D * DFF / 2};
        MoeOrder S{tb[65] * 4, 4, (int)blockIdx.x, tb, nullptr, false};
        pg8::EpiStore E{YB, D, F.b_down, D, 1 << 30, 0, 0};
        for (int rep = 0; rep < PROBE_REP_MOE; ++rep) pg8::gemm_phase<pg8::EpiStore, MoeOrder, true, true>(F.lds, g, S, E, F.wave);
        if (BOTH(9)) GRID_BAR();
    }
    if (IN(10)) { moe_tables(F); phase_f(F); }
#undef IN
#undef BOTH
}

extern "C" void kernel_launch(void* const* d_in, const int* in_sizes, int n_in, void* d_out, int out_size, void* d_ws, size_t ws_size, hipStream_t stream) {
    static int grid = 0;
    if (grid == 0) {
        if (n_in != 24 || in_sizes[0] != M * D || out_size != M * D || ws_size < WS_END) { fprintf(stderr, "kernel_launch: unexpected shapes (n_in %d, in0 %d, out %d, ws %zu); nothing launched\n", n_in, n_in > 0 ? in_sizes[0] : -1, out_size, ws_size); grid = -1; return; }
        int dev = 0, cus = 0, per_cu = 0;
        if (hipGetDevice(&dev) != hipSuccess || hipDeviceGetAttribute(&cus, hipDeviceAttributeMultiprocessorCount, dev) != hipSuccess) { grid = -1; return; }
        if (hipFuncSetAttribute((const void*)mk_fwd, hipFuncAttributeMaxDynamicSharedMemorySize, LDS_BYTES) != hipSuccess) { fprintf(stderr, "kernel_launch: hipFuncSetAttribute failed\n"); grid = -1; return; }
        if (hipOccupancyMaxActiveBlocksPerMultiprocessor(&per_cu, (const void*)mk_fwd, NWAVES * 64, LDS_BYTES) != hipSuccess || per_cu < 1)
            fprintf(stderr, "kernel_launch: occupancy query reports %d workgroups per CU\n", per_cu);
        (void)hipGetLastError();
        grid = cus;
        if (grid != 256) fprintf(stderr, "kernel_launch: %d CUs; this kernel is built for 256\n", grid);
    }
    if (grid < 0) return;
    if (hipMemsetAsync((char*)d_ws + WS_CTL, 0, CTL_ZERO_BYTES, stream) != hipSuccess) { fprintf(stderr, "kernel_launch: memset failed\n"); return; }
    Args a{};
    for (int i = 0; i < 24; ++i) a.in[i] = (const float*)d_in[i];
    a.out = (float*)d_out; a.ws = (unsigned char*)d_ws;
#if MK_PER_PHASE
    for (int p = 0; p < N_PHASES; ++p) { a.ph_lo = p; a.ph_hi = p + 1; hipLaunchKernelGGL(mk_fwd, dim3(grid), dim3(NWAVES * 64), LDS_BYTES, stream, a); }
#else
    a.ph_lo = 0; a.ph_hi = N_PHASES; hipLaunchKernelGGL(mk_fwd, dim3(grid), dim3(NWAVES * 64), LDS_BYTES, stream, a);
#endif
    const hipError_t le = hipPeekAtLastError();
    if (le != hipSuccess) fprintf(stderr, "kernel_launch: launch failed: %s\n", hipGetErrorName(le));
}
```

```cpp
#include <hip/hip_runtime.h>
#include <hip/hip_bf16.h>
#include <cstdio>
#include <cstdint>
#include <cmath>

#ifndef PROBE_REP_MOE
#define PROBE_REP_MOE 1
#endif
#ifndef PROBE_REP_G1
#define PROBE_REP_G1 1
#endif
#ifndef MK_PER_PHASE
#define MK_PER_PHASE 0
#endif

#define LAS __attribute__((address_space(3)))
#define GAS __attribute__((address_space(1)))
typedef unsigned short bf16_t;
typedef short bf16x8 __attribute__((ext_vector_type(8)));
typedef short s16x4 __attribute__((ext_vector_type(4)));
typedef float f32x4 __attribute__((ext_vector_type(4)));
typedef float f32x2 __attribute__((ext_vector_type(2)));
typedef float f32x16 __attribute__((ext_vector_type(16)));
typedef unsigned u32x4 __attribute__((ext_vector_type(4)));
typedef unsigned u32x2 __attribute__((ext_vector_type(2)));
typedef GAS unsigned gu32;
typedef int v4i __attribute__((ext_vector_type(4)));
typedef int v8i __attribute__((ext_vector_type(8)));
__device__ __forceinline__ unsigned cvt4_fp8(float a, float b, float c, float d) {
    a = fminf(fmaxf(a, -448.f), 448.f); b = fminf(fmaxf(b, -448.f), 448.f); c = fminf(fmaxf(c, -448.f), 448.f); d = fminf(fmaxf(d, -448.f), 448.f);
    int w = __builtin_amdgcn_cvt_pk_fp8_f32(a, b, 0, false); w = __builtin_amdgcn_cvt_pk_fp8_f32(c, d, w, true); return (unsigned)w; }
constexpr int FP8_SCALE_Q = 0x7C7C7C7C;
constexpr int FP8_SCALE_ONE = 0x7F7F7F7F, FP8_SCALE_W = 0x7A7A7A7A;
constexpr float FP8_W_MUL = 32.0f;

constexpr int BATCH = 2, SEQ = 8192, D = 1024, M = BATCH * SEQ;
constexpr int NH = 8, DH = 64, INW = 8192;
constexpr int NE = 32, TOPK = 4, DFF = 1024;
constexpr int CONV_FP8_PLANES = 1;
constexpr int C_Q = 0, C_K = 1024, C_V = 2048, C_CB = 3072, C_CC = 4096, C_CX = 5120, C_GA = 6144, C_GC = 7168;
__host__ __device__ constexpr size_t PL(int C) { return (size_t)(C / 1024) * (size_t)(2 * 8192) * 1024; }
constexpr float RMS_EPS = 1e-6f, SUBLN_EPS = 1e-5f, LAMBDA_INIT = 0.2f;
constexpr float SW_LIMIT = 7.0f, SW_ALPHA = 1.702f;
constexpr float LOG2E = 1.4426950408889634f;
constexpr float QSCALE = 0.125f * LOG2E;
constexpr int ECAP = 16384;
constexpr int MAXTILES = 320;
constexpr int SLOT_ROWS = MAXTILES * 256;

constexpr size_t MiB = 1u << 20;
constexpr size_t WS_CTL = 0, CTL_ZERO_BYTES = 32 * 1024;
constexpr size_t WS_MODP = 1 * MiB;
constexpr size_t WS_MOD = 2 * MiB;
constexpr size_t WS_ROPE = 3 * MiB;
constexpr size_t WS_LIST = 5 * MiB;
constexpr size_t WS_PAIR = 7 * MiB;
constexpr size_t WS_WAO = 8 * MiB, WS_WCO = 10 * MiB, WS_WOUT = 12 * MiB;
constexpr size_t WS_WIN = 16 * MiB;
constexpr size_t WS_WGU = 32 * MiB;
constexpr size_t WS_WD = 160 * MiB;
constexpr size_t WS_XN = 224 * MiB;
constexpr size_t WS_MM = 256 * MiB;
constexpr size_t WS_PROJ = 288 * MiB;
constexpr size_t WS_ACT = 544 * MiB;
constexpr size_t WS_Z = WS_ACT;
constexpr size_t WS_ON = WS_ACT + 32 * MiB;
constexpr size_t WS_Y = 704 * MiB;
constexpr size_t WS_KT = 864 * MiB;
constexpr size_t WS_VT = 896 * MiB;
constexpr size_t WS_XN8 = 928 * MiB;
constexpr size_t WS_Q8 = 944 * MiB;
constexpr size_t WS_END = 960 * MiB;
constexpr int CW_TMO = 0, CW_CODE = 1;
constexpr int CW_KMAX = 128;
constexpr int CW_CNT = 64;
constexpr int CW_BAR = 4096;

constexpr int RING_BYTES = 131072;
constexpr int TBL_OFF = 136192;
constexpr int WSF_OFF = 141312;
constexpr int MISC_OFF = 143360;
constexpr int LDS_BYTES = 147456;

#define RLX_AGENT __ATOMIC_RELAXED, __HIP_MEMORY_SCOPE_AGENT
#define LDS_WAIT() asm volatile("s_waitcnt lgkmcnt(0)" ::: "memory")
#define VM_WAIT() asm volatile("s_waitcnt vmcnt(0)" ::: "memory")

__device__ __forceinline__ unsigned f2bf(float f) { unsigned u = __builtin_bit_cast(unsigned, f); return (u + 0x7fffu + ((u >> 16) & 1u)) >> 16; }
__device__ __forceinline__ unsigned pk2(float lo, float hi) { return f2bf(lo) | (f2bf(hi) << 16); }
__device__ __forceinline__ float bflo(unsigned w) { return __builtin_bit_cast(float, w << 16); }
__device__ __forceinline__ float bfhi(unsigned w) { return __builtin_bit_cast(float, w & 0xffff0000u); }
__device__ __forceinline__ unsigned cvt_pk_bf16(float lo, float hi) { unsigned r; asm volatile("v_cvt_pk_bf16_f32 %0, %1, %2" : "=v"(r) : "v"(lo), "v"(hi)); return r; }
__device__ __forceinline__ float sigmoidf_fast(float v) { return __builtin_amdgcn_rcpf(1.0f + __builtin_amdgcn_exp2f(-LOG2E * v)); }
__device__ __forceinline__ int lane_opaque() { int l; asm volatile("v_mbcnt_lo_u32_b32 %0, -1, 0\n\tv_mbcnt_hi_u32_b32 %0, -1, %0" : "=v"(l)); return l; }
__device__ __forceinline__ void store16_wt(void* p, u32x4 v) { asm volatile("global_store_dwordx4 %0, %1, off sc1\n\ts_nop 1" :: "v"(p), "v"(v) : "memory"); }
__device__ __forceinline__ float wave_sum(float v) {
#pragma unroll
    for (int o = 1; o < 64; o <<= 1) v += __shfl_xor(v, o);
    return v;
}

namespace pg8 {
__device__ __forceinline__ const char* uni_ptr(const char* p) { const unsigned long long v = (unsigned long long)p; const unsigned lo = __builtin_amdgcn_readfirstlane((unsigned)v), hi = __builtin_amdgcn_readfirstlane((unsigned)(v >> 32)); return (const char*)(((unsigned long long)hi << 32) | lo); }
constexpr int BM = 256, BK = 64, HALF = 128, HTB = HALF * BK * 2, STAGE_BYTES = 8 * HTB, NXCD = 8, WGM = 8;
__host__ __device__ __forceinline__ int lds_byte(int r, int c) { const int st = (r >> 4) * 2 + (c >> 5), rr = r & 15, cc = c & 31, ob = rr * 64 + cc * 2; return st * 1024 + (ob ^ (((ob >> 9) & 1) << 5)); }
__host__ __device__ __forceinline__ void stage_rc(int b, int& R, int& C) { const int st = b / 1024, sb = b % 1024, swz = sb ^ (((sb >> 9) & 1) << 5); R = (st >> 1) * 16 + swz / 64; C = (st & 1) * 32 + (swz % 64) / 2; }
__host__ __device__ __forceinline__ int perm32(int rho) { const int n = rho >> 4, i = rho & 15; return 8 * (i >> 2) + 4 * n + (i & 3); }

struct Unit { int pm, pn, e; };
struct Gemm { const bf16_t* A; const bf16_t* Bt; int lda, K; size_t bstride; };

struct StaticOrder {
    int nM, nN, nwg, G, c;
    __device__ void init(int Mr, int N, int G_, int c_) { nM = Mr / BM; nN = N / BM; nwg = nM * nN; G = G_; c = c_; }
    __device__ bool next(int i, Unit& u) const {
        const long L = (long)i * G + c; if (L >= nwg) return false;
        int wgid = (int)L; { const int q = nwg / NXCD, r = nwg % NXCD, xcd = wgid % NXCD, off = wgid / NXCD; wgid = (xcd < r ? xcd * (q + 1) : r * (q + 1) + (xcd - r) * q) + off; }
        const int nig = WGM * nN, gid = wgid / nig, fm = gid * WGM, gsz = (nM - fm) < WGM ? (nM - fm) : WGM;
        u.pm = fm + ((wgid % nig) % gsz); u.pn = (wgid % nig) / gsz; u.e = 0; return true;
    }
    __device__ __forceinline__ int arow(const Unit& u, int r) const { return u.pm * BM + r; }
    __device__ __forceinline__ int acol(const Unit&) const { return 0; }
};

template <class Epi, class Sched, bool ALIGN_EPI, bool FP8 = false>
__device__ __forceinline__ void gemm_phase(LAS unsigned char* lds, const Gemm g, const Sched& S, const Epi& E, int wid_in) {
    const int wid = __builtin_amdgcn_readfirstlane(wid_in), lane = lane_opaque(), tid = wid * 64 + lane, wr = wid >> 2, wc = wid & 3, fr = lane & 15, fq = lane >> 4;
    const int K = g.K, nt = K / BK, lda = g.lda;
    int Rr[2], Cc[2]; unsigned voffB[2];
#pragma unroll
    for (int i = 0; i < 2; ++i) { int R, C; stage_rc(tid * 16 + i * 8192, R, C); const int Rb = (R & ~31) + perm32(R & 31);
        Rr[i] = R; Cc[i] = C; voffB[i] = (unsigned)(Rb * K + C) * 2u; }
    const size_t kstep = (size_t)(BK * 2);
    const size_t hstepB = (size_t)HALF * K * 2;
    const size_t tstepB = 2 * hstepB;
    const unsigned ldsw = (unsigned)wid * 1024u, lds0u = (unsigned)__builtin_amdgcn_readfirstlane((int)(unsigned)(uintptr_t)lds);
    const int aoff = lds_byte(wr * 64 + fr, FP8 ? fq * 16 : fq * 8), boff = lds_byte(wc * 32 + fr, FP8 ? fq * 16 : fq * 8);
    const int aoff1 = lds_byte(wr * 64 + fr, fq * 16 + 8), boff1 = lds_byte(wc * 32 + fr, fq * 16 + 8);
#define PG8_SA(b, h) (((b) * 2 + (h)) * HTB)
#define PG8_SB(b, h) ((4 + (b) * 2 + (h)) * HTB)
#define PG8_STAGE(bufoff, gbase, voff) do { unsigned _keep; const unsigned _l0 = lds0u + (unsigned)(bufoff) + ldsw; \
        asm volatile("s_mov_b32 %0, m0\n\ts_mov_b32 m0, %3\n\ts_nop 0\n\tglobal_load_lds_dwordx4 %1, %2\n\ts_mov_b32 m0, %4\n\ts_nop 0\n\tglobal_load_lds_dwordx4 %5, %2\n\ts_mov_b32 m0, %0" \
                     : "=&s"(_keep) : "v"((voff)[0]), "s"((const char*)(gbase)), "s"(_l0), "s"(_l0 + 8192u), "v"((voff)[1]) : "memory"); } while (0)
#define PG8_LD8(p0, p1) __builtin_shufflevector(*(const LAS v4i*)(p0), *(const LAS v4i*)(p1), 0, 1, 2, 3, 4, 5, 6, 7)
#define PG8_LDA(dst, b, h) do { if constexpr (FP8) { _Pragma("unroll") for (int m = 0; m < 4; ++m) dst##8[m] = PG8_LD8(lds + PG8_SA(b, h) + aoff + m * 2048, lds + PG8_SA(b, h) + aoff1 + m * 2048); } \
        else { _Pragma("unroll") for (int m = 0; m < 4; ++m) _Pragma("unroll") for (int k = 0; k < 2; ++k) dst[m][k] = *(const LAS bf16x8*)(lds + PG8_SA(b, h) + aoff + m * 2048 + k * 1024); } } while (0)
#define PG8_LDB(dst, b, h) do { if constexpr (FP8) { _Pragma("unroll") for (int n = 0; n < 2; ++n) dst##8[n] = PG8_LD8(lds + PG8_SB(b, h) + boff + n * 2048, lds + PG8_SB(b, h) + boff1 + n * 2048); } \
        else { _Pragma("unroll") for (int n = 0; n < 2; ++n) _Pragma("unroll") for (int k = 0; k < 2; ++k) dst[n][k] = *(const LAS bf16x8*)(lds + PG8_SB(b, h) + boff + n * 2048 + k * 1024); } } while (0)
#define PG8_MMA(ai, bj, At, Bt) do { __builtin_amdgcn_s_setprio(1); _Pragma("unroll") for (int m = 0; m < 4; ++m) _Pragma("unroll") for (int n = 0; n < 2; ++n) { \
        if constexpr (FP8) { asm volatile("v_mfma_scale_f32_16x16x128_f8f6f4 %0, %1, %2, %0, %3, %4 op_sel_hi:[0,0,0]" : "+v"(acc[ai][bj][m][n]) : "v"(Bt##8[n]), "v"(At##8[m]), "v"(sclW), "v"(sclX)); } \
        else { _Pragma("unroll") for (int k = 0; k < 2; ++k) acc[ai][bj][m][n] = __builtin_amdgcn_mfma_f32_16x16x32_bf16(Bt[n][k], At[m][k], acc[ai][bj][m][n], 0, 0, 0); } } __builtin_amdgcn_s_setprio(0); } while (0)
#define PG8_WAIT_V(n) asm volatile("s_waitcnt vmcnt(" #n ")" ::: "memory")
#define PG8_WAIT_L(n) asm volatile("s_waitcnt lgkmcnt(" #n ")" ::: "memory")
#define PG8_BAR __builtin_amdgcn_s_barrier()
#define PG8_SCHED __builtin_amdgcn_sched_barrier(0)
#define PG8_AOFF(dst, u) do { _Pragma("unroll") for (int _h = 0; _h < 2; ++_h) _Pragma("unroll") for (int _i = 0; _i < 2; ++_i) \
        dst[_h][_i] = ((unsigned)S.arow(u, _h * HALF + Rr[_i]) * (unsigned)lda + (unsigned)(Cc[_i] + S.acol(u))) * 2u; } while (0)
    Unit cur, nxt; int ui = 0;
    if (!S.next(0, cur)) return;
    f32x4 acc[2][2][4][2];
#pragma unroll
    for (int a = 0; a < 2; ++a)
#pragma unroll
        for (int b = 0; b < 2; ++b)
#pragma unroll
            for (int m = 0; m < 4; ++m)
#pragma unroll
                for (int n = 0; n < 2; ++n) acc[a][b][m][n] = (f32x4){0.f, 0.f, 0.f, 0.f};
    bf16x8 At[4][2], B0[2][2], B1[2][2]; v8i At8[4], B08[2], B18[2]; int sclW = FP8_SCALE_W, sclX = FP8_SCALE_ONE; asm volatile("" : "+v"(sclW), "+v"(sclX));
    unsigned ca[2][2], na[2][2];
    PG8_AOFF(ca, cur);
    const char* const Ab = uni_ptr((const char*)g.A);
    const char* cB = uni_ptr((const char*)g.Bt + ((size_t)cur.e * g.bstride) * 2 + (size_t)cur.pn * tstepB);
    PG8_STAGE(PG8_SB(0, 0), cB, voffB); PG8_STAGE(PG8_SB(0, 1), cB + hstepB, voffB); PG8_STAGE(PG8_SA(0, 0), Ab, ca[0]); PG8_STAGE(PG8_SA(0, 1), Ab, ca[1]);
    if (wr == 1) PG8_BAR;
    PG8_WAIT_V(2); PG8_BAR;
    PG8_STAGE(PG8_SB(1, 0), cB + kstep, voffB); PG8_STAGE(PG8_SA(1, 0), Ab + kstep, ca[0]); PG8_STAGE(PG8_SB(1, 1), cB + hstepB + kstep, voffB);
    PG8_WAIT_V(6); PG8_BAR;
    for (;;) {
        const bool has_next = S.next(ui + 1, nxt);
        if (has_next) { PG8_AOFF(na, nxt); } else {
#pragma unroll
            for (int h = 0; h < 2; ++h)
#pragma unroll
                for (int i = 0; i < 2; ++i) na[h][i] = ca[h][i]; }
        const char* nB = has_next ? uni_ptr((const char*)g.Bt + ((size_t)nxt.e * g.bstride) * 2 + (size_t)nxt.pn * tstepB) : cB;
        for (int t = 0; t < nt; t += 2) {
            const bool last = (t == nt - 2);
            const size_t k1 = (size_t)(t + 1) * kstep;
            const size_t k2 = last ? 0 : (size_t)(t + 2) * kstep, k3 = k2 + kstep;
            const char* b2 = last ? nB : cB + (size_t)(t + 2) * kstep; const char* b3 = b2 + kstep;
            unsigned s2[2][2];
#pragma unroll
            for (int h = 0; h < 2; ++h)
#pragma unroll
                for (int i = 0; i < 2; ++i) s2[h][i] = last ? na[h][i] : ca[h][i];
            PG8_LDB(B0, 0, 0); PG8_LDB(B1, 0, 1); PG8_SCHED; PG8_LDA(At, 0, 0); PG8_STAGE(PG8_SA(1, 1), Ab + k1, ca[1]);
            PG8_WAIT_V(8); PG8_WAIT_L(0); PG8_BAR; PG8_MMA(0, 0, At, B0); PG8_MMA(0, 1, At, B1); PG8_BAR; PG8_SCHED;
            PG8_LDA(At, 0, 1); PG8_STAGE(PG8_SB(0, 0), b2, voffB); PG8_STAGE(PG8_SB(0, 1), b2 + hstepB, voffB); PG8_STAGE(PG8_SA(0, 0), Ab + k2, s2[0]);
            PG8_WAIT_V(8); PG8_WAIT_L(0); PG8_BAR; PG8_MMA(1, 0, At, B0); PG8_MMA(1, 1, At, B1); PG8_BAR; PG8_SCHED;
            PG8_LDB(B0, 1, 0); PG8_LDB(B1, 1, 1); PG8_SCHED; PG8_LDA(At, 1, 0); PG8_STAGE(PG8_SA(0, 1), Ab + k2, s2[1]);
            PG8_WAIT_V(8); PG8_WAIT_L(0); PG8_BAR; PG8_MMA(0, 0, At, B0); PG8_MMA(0, 1, At, B1); PG8_BAR; PG8_SCHED;
            PG8_LDA(At, 1, 1); PG8_STAGE(PG8_SB(1, 0), b3, voffB); PG8_STAGE(PG8_SB(1, 1), b3 + hstepB, voffB); PG8_STAGE(PG8_SA(1, 0), Ab + k3, s2[0]);
            PG8_WAIT_V(8); PG8_WAIT_L(0); PG8_BAR; PG8_MMA(1, 0, At, B0); PG8_MMA(1, 1, At, B1); PG8_BAR; PG8_SCHED;
        }
        if constexpr (ALIGN_EPI) { if (wr == 0) PG8_BAR; }
        if constexpr (FP8) asm volatile("s_nop 15\n\ts_nop 15" ::: "memory");
        if constexpr (Epi::CHAIN) {
            if (has_next) { E.mid(acc, cur, wr, wc, fr, fq); } else { E(acc, cur, wr, wc, fr, fq); }
            if (!has_next) break;
        } else {
        E(acc, cur, wr, wc, fr, fq);
        if (!has_next) break;
#pragma unroll
        for (int a = 0; a < 2; ++a)
#pragma unroll
            for (int b = 0; b < 2; ++b)
#pragma unroll
                for (int m = 0; m < 4; ++m)
#pragma unroll
                    for (int n = 0; n < 2; ++n) acc[a][b][m][n] = (f32x4){0.f, 0.f, 0.f, 0.f};
        }
        cur = nxt; cB = nB; ++ui;
#pragma unroll
        for (int h = 0; h < 2; ++h)
#pragma unroll
            for (int i = 0; i < 2; ++i) ca[h][i] = na[h][i];
        if constexpr (ALIGN_EPI) { if (wr == 1) PG8_BAR; }
    }
    PG8_WAIT_V(0);
    if constexpr (!ALIGN_EPI) { if (wr == 0) PG8_BAR; }
    PG8_BAR;
#undef PG8_SA
#undef PG8_SB
#undef PG8_STAGE
#undef PG8_LDA
#undef PG8_LDB
#undef PG8_MMA
#undef PG8_LD8
#undef PG8_WAIT_V
#undef PG8_WAIT_L
#undef PG8_BAR
#undef PG8_SCHED
#undef PG8_AOFF
}

struct EpiStore {
    static constexpr bool CHAIN = false;
    bf16_t* O; int ldc; const float* bias; int bias_stride; int pn_split, col_lo, col_hi;
    __device__ __forceinline__ void operator()(const f32x4 (&acc)[2][2][4][2], const Unit& u, int wr, int wc, int fr, int fq) const {
        const int row0 = u.pm * BM + wr * 64 + fr, col0 = (u.pn < pn_split ? col_lo + u.pn * BM : col_hi + (u.pn - pn_split) * BM) + wc * 32 + 8 * fq;
        f32x4 bv[2][2];
#pragma unroll
        for (int bj = 0; bj < 2; ++bj)
#pragma unroll
            for (int n = 0; n < 2; ++n) bv[bj][n] = bias ? *(const f32x4*)(bias + (size_t)u.e * bias_stride + col0 + bj * HALF + 4 * n) : (f32x4){0.f, 0.f, 0.f, 0.f};
#pragma unroll
        for (int ai = 0; ai < 2; ++ai)
#pragma unroll
            for (int m = 0; m < 4; ++m) { bf16_t* rowp = ldc ? O + (size_t)(row0 + ai * HALF + m * 16) * ldc + col0 : O + PL(col0) + (size_t)(row0 + ai * HALF + m * 16) * D + (col0 & 1023);
#pragma unroll
                for (int bj = 0; bj < 2; ++bj) { const f32x4 v0 = acc[ai][bj][m][0] + bv[bj][0], v1 = acc[ai][bj][m][1] + bv[bj][1];
                    u32x4 w; w.x = cvt_pk_bf16(v0[0], v0[1]); w.y = cvt_pk_bf16(v0[2], v0[3]); w.z = cvt_pk_bf16(v1[0], v1[1]); w.w = cvt_pk_bf16(v1[2], v1[3]);
                    store16_wt(rowp + bj * HALF, w); } }
    }
};
__device__ __forceinline__ float rowsum4(float x) {
    const auto p = __builtin_amdgcn_permlane16_swap(__float_as_uint(x), __float_as_uint(x), false, false); x = __uint_as_float(p[0]) + __uint_as_float(p[1]);
    const auto q = __builtin_amdgcn_permlane32_swap(__float_as_uint(x), __float_as_uint(x), false, false); return __uint_as_float(q[0]) + __uint_as_float(q[1]); }
struct EpiInProj {
    static constexpr bool CHAIN = false;
    EpiStore st; const float* qnw; const float* knw; const f32x2* cs; unsigned char* q8; unsigned char* kimg; unsigned* kmax; unsigned char* vimg;
    __device__ __forceinline__ void operator()(const f32x4 (&acc)[2][2][4][2], const Unit& u, int wr, int wc, int fr_, int fq_) const {
        (void)fr_; (void)fq_; const int lo_ = lane_opaque(), fr = lo_ & 15, fq = lo_ >> 4;
        if (u.pn >= 12) { st(acc, u, wr, wc, fr, fq); return; }
        if (u.pn >= 8) {
            const int T = 2 * wr + (fr >> 3), ks = (fr >> 1) & 3, hf = fr & 1, row0 = u.pm * BM, bb = row0 >> 13, tile = ((row0 & (SEQ - 1)) >> 6) + T;
#pragma unroll
            for (int bj = 0; bj < 2; ++bj) { const int hh = 2 * (u.pn - 8) + bj;
                unsigned char* vd = vimg + ((size_t)((bb * 8 + hh) * (SEQ / 64) + tile)) * 8192 + (size_t)wc * 2048 + hf * 1024 + 8 * ks;
#pragma unroll
                for (int n = 0; n < 2; ++n)
#pragma unroll
                    for (int jj = 0; jj < 4; ++jj) { const int dd = 8 * fq + 4 * n + jj; u32x2 o;
                        o.x = cvt4_fp8(acc[0][bj][0][n][jj], acc[0][bj][1][n][jj], acc[0][bj][2][n][jj], acc[0][bj][3][n][jj]);
                        o.y = cvt4_fp8(acc[1][bj][0][n][jj], acc[1][bj][1][n][jj], acc[1][bj][2][n][jj], acc[1][bj][3][n][jj]);
                        *(u32x2*)(vd + dd * 32) = o; } }
            return; }
        const int which = u.pn >> 2, grp = (u.pn & 3) * 4 + wc;
        const float* nw = which == 0 ? qnw : knw; const float osc = which == 0 ? QSCALE * 8.0f : 1.0f, n2s = which == 0 ? 1.0f / 64.0f : 1.0f;
        float w1[8], w2[8]; float kmax2 = 0.f;
#pragma unroll
        for (int j = 0; j < 8; ++j) { w1[j] = nw[8 * fq + j] * osc; w2[j] = nw[32 + 8 * fq + j] * osc; }
        const int rowb = u.pm * BM + wr * 64 + fr;
        f32x4 cvn[4];
        { const f32x4* cp = (const f32x4*)(cs + (size_t)(rowb & (SEQ - 1)) * 32 + 8 * fq);
#pragma unroll
          for (int jj = 0; jj < 4; ++jj) cvn[jj] = cp[jj]; }
#pragma unroll
        for (int ai = 0; ai < 2; ++ai)
#pragma unroll
            for (int m = 0; m < 4; ++m) { const int row = rowb + ai * HALF + m * 16, t = row & (SEQ - 1);
                const f32x4 a0 = acc[ai][0][m][0], a1 = acc[ai][0][m][1], c0 = acc[ai][1][m][0], c1 = acc[ai][1][m][1];
                const float t1[8] = {a0[0], a0[1], a0[2], a0[3], a1[0], a1[1], a1[2], a1[3]}, t2[8] = {c0[0], c0[1], c0[2], c0[3], c1[0], c1[1], c1[2], c1[3]};
                float ss = 0.f;
#pragma unroll
                for (int j = 0; j < 8; ++j) ss += t1[j] * t1[j] + t2[j] * t2[j];
                ss = rowsum4(ss);
                const float rstd = 1.0f / sqrtf(ss * (1.0f / 64.0f) + RMS_EPS);
                float o1[8], o2[8];
#pragma unroll
                for (int jj = 0; jj < 4; ++jj) { const f32x4 cv = cvn[jj];
#pragma unroll
                    for (int q = 0; q < 2; ++q) { const int j = 2 * jj + q; const float co = q ? cv[2] : cv[0], si = q ? cv[3] : cv[1];
                        const float u1 = t1[j] * rstd * w1[j], u2 = t2[j] * rstd * w2[j];
                        o1[j] = u1 * co - u2 * si; o2[j] = u2 * co + u1 * si; } }
                __builtin_amdgcn_sched_barrier(0);
                if (ai * 4 + m < 7) { const int rn = rowb + ((ai * 4 + m + 1) >> 2) * HALF + ((ai * 4 + m + 1) & 3) * 16; const f32x4* cp = (const f32x4*)(cs + (size_t)(rn & (SEQ - 1)) * 32 + 8 * fq);
#pragma unroll
                    for (int jj = 0; jj < 4; ++jj) cvn[jj] = cp[jj]; }
                u32x2 wa, wc2;
                wa.x = cvt4_fp8(o1[0], o1[1], o1[2], o1[3]); wa.y = cvt4_fp8(o1[4], o1[5], o1[6], o1[7]);
                wc2.x = cvt4_fp8(o2[0], o2[1], o2[2], o2[3]); wc2.y = cvt4_fp8(o2[4], o2[5], o2[6], o2[7]);
                { float n2 = 0.f;
#pragma unroll
                    for (int j = 0; j < 8; ++j) n2 += o1[j] * o1[j] + o2[j] * o2[j];
                    n2 = rowsum4(n2); kmax2 = fmaxf(kmax2, n2); }
                if (which == 0) { unsigned char* qd = q8 + (size_t)row * D + 64 * grp + 8 * fq; *(u32x2*)qd = wa; *(u32x2*)(qd + 32) = wc2; }
                else { const int bb = row >> 13, key = t, hh = grp >> 1, cmp = grp & 1;
                    unsigned char* kd = kimg + ((size_t)((bb * 8 + hh) * (SEQ / 64) + (key >> 6))) * 8192 + cmp * 4096 + ((key & 63) >> 5) * 2048 + (key & 31) * 32 + 8 * fq;
                    *(u32x2*)kd = wa; *(u32x2*)(kd + 1024) = wc2; } }
        kmax2 = fmaxf(kmax2, __shfl_xor(kmax2, 1)); kmax2 = fmaxf(kmax2, __shfl_xor(kmax2, 2)); kmax2 = fmaxf(kmax2, __shfl_xor(kmax2, 4)); kmax2 = fmaxf(kmax2, __shfl_xor(kmax2, 8));
        if (fr == 0 && fq == 0) atomicMax(kmax + which * 32 + ((u.pm * BM) >> 13) * 16 + grp, __float_as_uint(kmax2 * n2s));
    }
};
template <bool ADD> struct EpiGate {
    static constexpr bool CHAIN = false;
    bf16_t* O; const bf16_t* gate; int ldg;
    __device__ __forceinline__ void operator()(const f32x4 (&acc)[2][2][4][2], const Unit& u, int wr, int wc, int fr, int fq) const {
        const int row0 = u.pm * BM + wr * 64 + fr, col0 = u.pn * BM + wc * 32 + 8 * fq;
#pragma unroll
        for (int ai = 0; ai < 2; ++ai)
#pragma unroll
            for (int m = 0; m < 4; ++m) { const size_t row = (size_t)(row0 + ai * HALF + m * 16);
#pragma unroll
                for (int bj = 0; bj < 2; ++bj) {
                    const u32x4 gv = *(const u32x4*)(gate + row * ldg + col0 + bj * HALF);
                    bf16_t* op = O + row * D + col0 + bj * HALF;
                    const f32x4 a0 = acc[ai][bj][m][0], a1 = acc[ai][bj][m][1];
                    float r[8];
                    r[0] = sigmoidf_fast(bflo(gv.x)) * a0[0]; r[1] = sigmoidf_fast(bfhi(gv.x)) * a0[1]; r[2] = sigmoidf_fast(bflo(gv.y)) * a0[2]; r[3] = sigmoidf_fast(bfhi(gv.y)) * a0[3];
                    r[4] = sigmoidf_fast(bflo(gv.z)) * a1[0]; r[5] = sigmoidf_fast(bfhi(gv.z)) * a1[1]; r[6] = sigmoidf_fast(bflo(gv.w)) * a1[2]; r[7] = sigmoidf_fast(bfhi(gv.w)) * a1[3];
                    if (ADD) { const u32x4 pv = *(const u32x4*)op;
                        r[0] += bflo(pv.x); r[1] += bfhi(pv.x); r[2] += bflo(pv.y); r[3] += bfhi(pv.y); r[4] += bflo(pv.z); r[5] += bfhi(pv.z); r[6] += bflo(pv.w); r[7] += bfhi(pv.w); }
                    u32x4 w; w.x = cvt_pk_bf16(r[0], r[1]); w.y = cvt_pk_bf16(r[2], r[3]); w.z = cvt_pk_bf16(r[4], r[5]); w.w = cvt_pk_bf16(r[6], r[7]);
                    *(u32x4*)op = w; } }
    }
};
struct EpiGateChain {
    static constexpr bool CHAIN = true;
    bf16_t* O; const bf16_t* ga; const bf16_t* gc; int ldg;
    __device__ __forceinline__ void mid(f32x4 (&acc)[2][2][4][2], const Unit& u, int wr, int wc, int fr, int fq) const {
        const int row0 = u.pm * BM + wr * 64 + fr, col0 = u.pn * BM + wc * 32 + 8 * fq;
#pragma unroll
        for (int ai = 0; ai < 2; ++ai) { u32x4 avv[4][2], cvv[4][2];
#pragma unroll
            for (int m = 0; m < 4; ++m)
#pragma unroll
                for (int bj = 0; bj < 2; ++bj) { const size_t o = (size_t)(row0 + ai * HALF + m * 16) * ldg + col0 + bj * HALF; avv[m][bj] = *(const u32x4*)(ga + o); cvv[m][bj] = *(const u32x4*)(gc + o); }
            __builtin_amdgcn_sched_barrier(0);
#pragma unroll
            for (int m = 0; m < 4; ++m)
#pragma unroll
                for (int bj = 0; bj < 2; ++bj) { const u32x4 av = avv[m][bj], cv = cvv[m][bj];
                    const float a8[8] = {bflo(av.x), bfhi(av.x), bflo(av.y), bfhi(av.y), bflo(av.z), bfhi(av.z), bflo(av.w), bfhi(av.w)};
                    const float c8[8] = {bflo(cv.x), bfhi(cv.x), bflo(cv.y), bfhi(cv.y), bflo(cv.z), bfhi(cv.z), bflo(cv.w), bfhi(cv.w)};
#pragma unroll
                    for (int e = 0; e < 8; ++e) { const float r = sigmoidf_fast(c8[e]) * (1.0f + __builtin_amdgcn_exp2f(-LOG2E * fmaxf(a8[e], -60.0f)));
                        if (e < 4) acc[ai][bj][m][0][e] *= r; else acc[ai][bj][m][1][e - 4] *= r; } }
            __builtin_amdgcn_sched_barrier(0); }
    }
    __device__ __forceinline__ void operator()(const f32x4 (&acc)[2][2][4][2], const Unit& u, int wr, int wc, int fr, int fq) const {
        const int row0 = u.pm * BM + wr * 64 + fr, col0 = u.pn * BM + wc * 32 + 8 * fq;
        u32x4 avv[2][4][2];
#pragma unroll
        for (int ai = 0; ai < 2; ++ai)
#pragma unroll
            for (int m = 0; m < 4; ++m)
#pragma unroll
                for (int bj = 0; bj < 2; ++bj) avv[ai][m][bj] = *(const u32x4*)(ga + (size_t)(row0 + ai * HALF + m * 16) * ldg + col0 + bj * HALF);
        __builtin_amdgcn_sched_barrier(0);
#pragma unroll
        for (int ai = 0; ai < 2; ++ai)
#pragma unroll
            for (int m = 0; m < 4; ++m) { const size_t row = (size_t)(row0 + ai * HALF + m * 16);
#pragma unroll
                for (int bj = 0; bj < 2; ++bj) {
                    const u32x4 av = avv[ai][m][bj];
                    const float a8[8] = {bflo(av.x), bfhi(av.x), bflo(av.y), bfhi(av.y), bflo(av.z), bfhi(av.z), bflo(av.w), bfhi(av.w)};
                    const f32x4 a0 = acc[ai][bj][m][0], a1 = acc[ai][bj][m][1]; float r[8];
#pragma unroll
                    for (int e = 0; e < 8; ++e) r[e] = sigmoidf_fast(fmaxf(a8[e], -60.0f)) * (e < 4 ? a0[e] : a1[e - 4]);
                    u32x4 w; w.x = cvt_pk_bf16(r[0], r[1]); w.y = cvt_pk_bf16(r[2], r[3]); w.z = cvt_pk_bf16(r[4], r[5]); w.w = cvt_pk_bf16(r[6], r[7]);
                    *(u32x4*)(O + row * D + col0 + bj * HALF) = w; } }
    }
};
struct EpiResid {
    static constexpr bool CHAIN = false;
    const float* x; float* out; const float* g;
    __device__ __forceinline__ void operator()(const f32x4 (&acc)[2][2][4][2], const Unit& u, int wr, int wc, int fr, int fq) const {
        const int row0 = u.pm * BM + wr * 64 + fr, col0 = u.pn * BM + wc * 32 + 8 * fq;
        const float* gb = g + (u.pm >= (SEQ / BM) ? 6144 : 0);
        f32x4 gv[2][2];
#pragma unroll
        for (int bj = 0; bj < 2; ++bj)
#pragma unroll
            for (int n = 0; n < 2; ++n) gv[bj][n] = *(const f32x4*)(gb + col0 + bj * HALF + 4 * n);
#pragma unroll
        for (int ai = 0; ai < 2; ++ai) { f32x4 xv[4][2][2];
#pragma unroll
            for (int m = 0; m < 4; ++m)
#pragma unroll
                for (int bj = 0; bj < 2; ++bj)
#pragma unroll
                    for (int n = 0; n < 2; ++n) xv[m][bj][n] = *(const f32x4*)(x + (size_t)(row0 + ai * HALF + m * 16) * D + col0 + bj * HALF + 4 * n);
            __builtin_amdgcn_sched_barrier(0);
#pragma unroll
            for (int m = 0; m < 4; ++m) { const size_t off = (size_t)(row0 + ai * HALF + m * 16) * D + col0;
#pragma unroll
                for (int bj = 0; bj < 2; ++bj)
#pragma unroll
                    for (int n = 0; n < 2; ++n) *(f32x4*)(out + off + bj * HALF + 4 * n) = xv[m][bj][n] + gv[bj][n] * acc[ai][bj][m][n]; }
            __builtin_amdgcn_sched_barrier(0); }
    }
};
struct EpiSwiglu {
    static constexpr bool CHAIN = false;
    unsigned char* O; const float* bias;
    __device__ __forceinline__ void operator()(const f32x4 (&acc)[2][2][4][2], const Unit& u, int wr, int wc, int fr, int fq) const {
        const int row0 = u.pm * BM + wr * 64 + fr, col0 = u.pn * BM + wc * 32 + 8 * fq;
        f32x4 bv[2][2];
#pragma unroll
        for (int bj = 0; bj < 2; ++bj)
#pragma unroll
            for (int n = 0; n < 2; ++n) bv[bj][n] = *(const f32x4*)(bias + (size_t)u.e * (2 * DFF) + col0 + bj * HALF + 4 * n);
#pragma unroll
        for (int ai = 0; ai < 2; ++ai)
#pragma unroll
            for (int m = 0; m < 4; ++m) { unsigned char* rowp = O + (size_t)(row0 + ai * HALF + m * 16) * DFF + (col0 >> 1);
#pragma unroll
                for (int bj = 0; bj < 2; ++bj) { const f32x4 v0 = acc[ai][bj][m][0] + bv[bj][0], v1 = acc[ai][bj][m][1] + bv[bj][1];
                    float r[4];
#pragma unroll
                    for (int p = 0; p < 4; ++p) { const float gt = p < 2 ? v0[2 * p] : v1[2 * p - 4], up = p < 2 ? v0[2 * p + 1] : v1[2 * p - 3];
                        const float gc = fminf(gt, SW_LIMIT), uc = __builtin_amdgcn_fmed3f(up, -SW_LIMIT, SW_LIMIT);
                        const float z = gc * __builtin_amdgcn_rcpf(1.0f + __builtin_amdgcn_exp2f(gc * (-LOG2E * SW_ALPHA)));
                        r[p] = __builtin_fmaf(uc, z, z); }
                    int w8 = __builtin_amdgcn_cvt_pk_fp8_f32(r[0], r[1], 0, false); w8 = __builtin_amdgcn_cvt_pk_fp8_f32(r[2], r[3], w8, true);
                    *(unsigned*)(rowp + bj * (HALF / 2)) = (unsigned)w8; } }
    }
};
}

namespace attn {
constexpr int PITCH = INW;
constexpr int KVBLK = 64, NT = SEQ / KVBLK, NTB = NT / 2, NSLOT = 3, SLOTB = 16384;
constexpr int VSLOTB = 8192;
constexpr int LDS_K = 0, LDS_V = NSLOT * SLOTB;
constexpr int XROW = 132;
constexpr int XIMG = 32 * XROW * 4;
static_assert(8 * XIMG <= TBL_OFF && LDS_V + NSLOT * SLOTB <= RING_BYTES, "attention LDS map");
__device__ __forceinline__ int crow(int r, int hi) { return (r & 3) + 8 * (r >> 2) + 4 * hi; }
__device__ __forceinline__ void glds16(const void* gsrc, unsigned lds_dst) { unsigned keep;
    asm volatile("s_mov_b32 %0, m0\n\ts_mov_b32 m0, %2\n\ts_nop 0\n\tglobal_load_lds_dwordx4 %1, off\n\ts_mov_b32 m0, %0" : "=&s"(keep) : "v"(gsrc), "s"(lds_dst) : "memory"); }
__device__ __forceinline__ void glds16x2(const void* gsrc, unsigned lds_dst) { unsigned keep;
    asm volatile("s_mov_b32 %0, m0\n\ts_mov_b32 m0, %2\n\ts_nop 0\n\tglobal_load_lds_dwordx4 %1, off\n\tglobal_load_lds_dwordx4 %1, off offset:1024\n\ts_mov_b32 m0, %0" : "=&s"(keep) : "v"(gsrc), "s"(lds_dst) : "memory"); }
__device__ __forceinline__ void glds16x4(const void* gsrc, unsigned lds_dst) { unsigned keep;
    asm volatile("s_mov_b32 %0, m0\n\ts_mov_b32 m0, %2\n\ts_nop 0\n\tglobal_load_lds_dwordx4 %1, off\n\tglobal_load_lds_dwordx4 %1, off offset:1024\n\tglobal_load_lds_dwordx4 %1, off offset:2048\n\tglobal_load_lds_dwordx4 %1, off offset:3072\n\ts_mov_b32 m0, %0" : "=&s"(keep) : "v"(gsrc), "s"(lds_dst) : "memory"); }
__device__ __forceinline__ void glds16x4s(const void* sbase, unsigned voff, unsigned lds_dst) { unsigned keep;
    asm volatile("s_mov_b32 %0, m0\n\ts_mov_b32 m0, %3\n\ts_nop 0\n\tglobal_load_lds_dwordx4 %1, %2\n\tglobal_load_lds_dwordx4 %1, %2 offset:1024\n\tglobal_load_lds_dwordx4 %1, %2 offset:2048\n\tglobal_load_lds_dwordx4 %1, %2 offset:3072\n\ts_mov_b32 m0, %0" : "=&s"(keep) : "v"(voff), "s"(sbase), "s"(lds_dst) : "memory"); }
typedef LAS const char* lds_cptr;
typedef short v4i16_t __attribute__((ext_vector_type(4)));
__device__ __forceinline__ s16x4 vtr(lds_cptr p) { return __builtin_bit_cast(s16x4, __builtin_amdgcn_ds_read_tr16_b64_v4i16((LAS v4i16_t*)p)); }
typedef __bf16 bf16x2_t __attribute__((ext_vector_type(2)));
__device__ __forceinline__ unsigned cvtpk_s(float lo, float hi) { f32x2 v = {lo, hi}; bf16x2_t b = __builtin_convertvector(v, bf16x2_t); return __builtin_bit_cast(unsigned, b); }
#define ATT_WAIT_BAR(N) asm volatile("s_waitcnt vmcnt(" #N ") lgkmcnt(0)\n\ts_barrier" ::: "memory")

struct AttnState { f32x16 o0, o1, o2, o3; f32x16 p0, p1, p2, p3; v8i pa; v8i ones; f32x16 negm; f32x16 lacc; float mhat, l_reg; };
#define ATT_SB() __builtin_amdgcn_sched_barrier(0)
__device__ __forceinline__ unsigned cvt4_bf8(float a, float b, float c, float d);
__device__ __forceinline__ unsigned cvt4_bf8o(float a, float b, float c, float d, int old);
#define ATT_LD8(p) __builtin_shufflevector(*(const LAS v4i*)(p), *(const LAS v4i*)((p) + 16), 0, 1, 2, 3, 4, 5, 6, 7)
__device__ __forceinline__ void attn_kload(v8i (&kf)[4], lds_cptr kp) { kf[0] = ATT_LD8(kp); kf[1] = ATT_LD8(kp + 2048); kf[2] = ATT_LD8(kp + 8192); kf[3] = ATT_LD8(kp + 8192 + 2048); }
template <int THRL, bool FAST>
__device__ __forceinline__ void attn_s1(AttnState& st, const v8i (&kf)[4], const v8i& q8, bool first, int r32, int hi) {
    f32x16 p0, p1, p2, p3;
#define ATT_QK(KF, C) __builtin_amdgcn_mfma_scale_f32_32x32x64_f8f6f4(KF, q8, C, 0, 0, 0, FP8_SCALE_ONE, 0, FP8_SCALE_Q)
    if constexpr (FAST) {
        __builtin_amdgcn_s_setprio(1);
        p0 = ATT_QK(kf[0], f32x16{}); p1 = ATT_QK(kf[1], f32x16{}); p2 = ATT_QK(kf[2], f32x16{}); p3 = ATT_QK(kf[3], f32x16{});
        __builtin_amdgcn_s_setprio(0);
#pragma unroll
        for (int r = 0; r < 16; ++r) p0[r] = __builtin_amdgcn_exp2f(p0[r]);
#pragma unroll
        for (int r = 0; r < 16; ++r) p1[r] = __builtin_amdgcn_exp2f(p1[r]);
        {
#pragma unroll
          for (int k = 0; k < 4; ++k) { st.pa[k] = (int)cvt4_bf8o(p0[4 * k], p0[4 * k + 1], p0[4 * k + 2], p0[4 * k + 3], st.pa[k]); st.pa[4 + k] = (int)cvt4_bf8o(p1[4 * k], p1[4 * k + 1], p1[4 * k + 2], p1[4 * k + 3], st.pa[4 + k]); }
          asm volatile("" : "+v"(st.pa)); }
        st.p0 = p0; st.p1 = p1; st.p2 = p2; st.p3 = p3;
    } else {
    __builtin_amdgcn_s_setprio(1);
    p0 = ATT_QK(kf[0], st.negm); p1 = ATT_QK(kf[1], st.negm); p2 = ATT_QK(kf[2], st.negm); p3 = ATT_QK(kf[3], st.negm);
    __builtin_amdgcn_s_setprio(0);
    {
    float rm;
    { float a = fmaxf(fmaxf(p0[0], p0[1]), p1[0]), c = fmaxf(fmaxf(p0[2], p0[3]), p1[1]); a = fmaxf(fmaxf(a, p1[2]), p1[3]);
#pragma unroll
      for (int r = 4; r < 16; r += 4) { a = fmaxf(fmaxf(a, p0[r]), p0[r + 1]); c = fmaxf(fmaxf(c, p0[r + 2]), p0[r + 3]); a = fmaxf(fmaxf(a, p1[r]), p1[r + 1]); c = fmaxf(fmaxf(c, p1[r + 2]), p1[r + 3]); }
#pragma unroll
      for (int r = 0; r < 16; r += 4) { a = fmaxf(fmaxf(a, p2[r]), p2[r + 1]); c = fmaxf(fmaxf(c, p2[r + 2]), p2[r + 3]); a = fmaxf(fmaxf(a, p3[r]), p3[r + 1]); c = fmaxf(fmaxf(c, p3[r + 2]), p3[r + 3]); }
      rm = fmaxf(a, c); auto rr = __builtin_amdgcn_permlane32_swap(__float_as_uint(rm), __float_as_uint(rm), false, false); rm = fmaxf(__uint_as_float(rr[0]), __uint_as_float(rr[1])); }
    if (first || __any(rm > (float)THRL)) {
        const float dl = first ? rm : fmaxf(rm, 0.f); st.mhat += dl;
#pragma unroll
        for (int r = 0; r < 16; ++r) { p0[r] -= dl; p1[r] -= dl; p2[r] -= dl; p3[r] -= dl; }
#pragma unroll
        for (int r = 0; r < 16; ++r) st.negm[r] = -st.mhat;
        if (!first) {
            const float f = __builtin_amdgcn_exp2f(-dl); st.l_reg *= f;
#pragma unroll
            for (int r = 0; r < 16; ++r) { st.o0[r] *= f; st.o1[r] *= f; st.o2[r] *= f; st.o3[r] *= f; }
        }
    }
    }
#pragma unroll
    for (int r = 0; r < 16; ++r) { p0[r] = __builtin_amdgcn_exp2f(p0[r]); p1[r] = __builtin_amdgcn_exp2f(p1[r]); p2[r] = __builtin_amdgcn_exp2f(p2[r]); p3[r] = __builtin_amdgcn_exp2f(p3[r]); }
    st.p0 = p0; st.p1 = p1; st.p2 = p2; st.p3 = p3;
    }
#undef ATT_QK
}
__device__ __forceinline__ unsigned cvt4_bf8(float a, float b, float c, float d) { int w = __builtin_amdgcn_cvt_pk_bf8_f32(a, b, 0, false); w = __builtin_amdgcn_cvt_pk_bf8_f32(c, d, w, true); return (unsigned)w; }
__device__ __forceinline__ unsigned cvt4_bf8o(float a, float b, float c, float d, int old) { int w = __builtin_amdgcn_cvt_pk_bf8_f32(a, b, old, false); w = __builtin_amdgcn_cvt_pk_bf8_f32(c, d, w, true); return (unsigned)w; }
template <bool FAST>
__device__ __forceinline__ void attn_s2(AttnState& st, lds_cptr vp, v8i (&kf)[4], lds_cptr kpn) {
    int one = FP8_SCALE_ONE; asm volatile("" : "+v"(one));
    float sacc = 0.f;
    v8i ones8; if constexpr (FAST) ones8 = st.ones;
#define ATT_MM8(OD, VF, PB) asm volatile("s_nop 1\n\tv_mfma_scale_f32_32x32x64_f8f6f4 %0, %1, %2, %0, %3, %3 op_sel_hi:[0,0,0] blgp:1" : "+v"(OD) : "v"(VF), "v"(PB), "v"(one))
#define ATT_PB(PB, PA, PC) do { _Pragma("unroll") for (int k = 0; k < 4; ++k) { PB[k] = (int)cvt4_bf8(PA[4 * k], PA[4 * k + 1], PA[4 * k + 2], PA[4 * k + 3]); PB[4 + k] = (int)cvt4_bf8(PC[4 * k], PC[4 * k + 1], PC[4 * k + 2], PC[4 * k + 3]); \
        if constexpr (!FAST) sacc += ((PA[4 * k] + PA[4 * k + 1]) + (PA[4 * k + 2] + PA[4 * k + 3])) + ((PC[4 * k] + PC[4 * k + 1]) + (PC[4 * k + 2] + PC[4 * k + 3])); } } while (0)
    v8i vf[4], paloc; v8i& pa = *(FAST ? &st.pa : &paloc);
    ATT_SB();
#pragma unroll
    for (int d = 0; d < 4; ++d) vf[d] = ATT_LD8(vp + d * 2048);
    if constexpr (!FAST) ATT_PB(pa, st.p0, st.p1);
    ATT_SB();
    if constexpr (FAST) {
        ATT_MM8(st.o0, vf[0], pa); ATT_SB(); vf[0] = ATT_LD8(vp + 8192);
#pragma unroll
        for (int r = 0; r < 8; ++r) st.p2[r] = __builtin_amdgcn_exp2f(st.p2[r]);
        ATT_SB();
        ATT_MM8(st.o1, vf[1], pa); ATT_SB(); vf[1] = ATT_LD8(vp + 8192 + 2048);
#pragma unroll
        for (int r = 8; r < 16; ++r) st.p2[r] = __builtin_amdgcn_exp2f(st.p2[r]);
        ATT_SB();
        ATT_MM8(st.o2, vf[2], pa); ATT_SB(); vf[2] = ATT_LD8(vp + 8192 + 2 * 2048);
#pragma unroll
        for (int r = 0; r < 8; ++r) st.p3[r] = __builtin_amdgcn_exp2f(st.p3[r]);
        ATT_SB();
        ATT_MM8(st.o3, vf[3], pa); ATT_SB(); vf[3] = ATT_LD8(vp + 8192 + 3 * 2048);
#pragma unroll
        for (int r = 8; r < 16; ++r) st.p3[r] = __builtin_amdgcn_exp2f(st.p3[r]);
        ATT_SB();
        ATT_MM8(st.lacc, ones8, pa); ATT_SB();
        {
#pragma unroll
          for (int k = 0; k < 4; ++k) { pa[k] = (int)cvt4_bf8o(st.p2[4 * k], st.p2[4 * k + 1], st.p2[4 * k + 2], st.p2[4 * k + 3], pa[k]); pa[4 + k] = (int)cvt4_bf8o(st.p3[4 * k], st.p3[4 * k + 1], st.p3[4 * k + 2], st.p3[4 * k + 3], pa[4 + k]); } }
        kf[0] = ATT_LD8(kpn); kf[1] = ATT_LD8(kpn + 2048);
        ATT_SB();
    } else {
    ATT_MM8(st.o0, vf[0], pa); ATT_MM8(st.o1, vf[1], pa); ATT_MM8(st.o2, vf[2], pa); ATT_MM8(st.o3, vf[3], pa);
    ATT_SB();
#pragma unroll
    for (int d = 0; d < 4; ++d) vf[d] = ATT_LD8(vp + 8192 + d * 2048);
    ATT_PB(pa, st.p2, st.p3);
    kf[0] = ATT_LD8(kpn); kf[1] = ATT_LD8(kpn + 2048);
    ATT_SB();
    }
    ATT_MM8(st.o0, vf[0], pa); ATT_MM8(st.o1, vf[1], pa); ATT_MM8(st.o2, vf[2], pa); ATT_MM8(st.o3, vf[3], pa);
    if constexpr (FAST) ATT_MM8(st.lacc, ones8, pa);
    kf[2] = ATT_LD8(kpn + 8192); kf[3] = ATT_LD8(kpn + 8192 + 2048);
    asm volatile("s_nop 15\n\ts_nop 7" ::: "memory");
    ATT_SB();
    if constexpr (!FAST) st.l_reg += sacc;
#undef ATT_MM8
#undef ATT_PB
}

constexpr int BG_ITEMS = NE * (32 * 64 + 32 * 32);
constexpr int BG_LDS = NSLOT * 2 * SLOTB;
struct BgCtx { const float* wgu; const float* wdn; unsigned char* tgu; unsigned char* tdn; };
struct BgItem { const float* src; unsigned char* dst; int N; };
__device__ __forceinline__ bool bg_decode(const BgCtx& c, int g, BgItem& it) {
    if (g >= BG_ITEMS) return false;
    const int e = g / 3072; int r = g % 3072;
    if (r < 2048) { const int nb = r >> 5, kb = r & 31; it.N = 2 * DFF; it.src = c.wgu + (size_t)e * D * 2 * DFF + (size_t)(32 * kb) * (2 * DFF) + 32 * nb; it.dst = c.tgu + (size_t)e * 2 * DFF * D + (size_t)(32 * nb) * D + 32 * kb; }
    else { r -= 2048; const int nb = r >> 5, kb = r & 31; it.N = D; it.src = c.wdn + (size_t)e * DFF * D + (size_t)(32 * kb) * D + 32 * nb; it.dst = c.tdn + (size_t)e * D * DFF + (size_t)(32 * nb) * DFF + 32 * kb; }
    return true;
}
__device__ __forceinline__ void bg_issue(const BgItem& it, unsigned lds_dst, int lane) { unsigned keep;
    const char* p0 = (const char*)(it.src + (size_t)(lane >> 3) * it.N + (lane & 7) * 4);
    const size_t rs = (size_t)8 * it.N * 4;
    const char* p1 = p0 + rs - 1024; const char* p2 = p0 + 2 * rs - 2048; const char* p3 = p0 + 3 * rs - 3072;
    asm volatile("s_mov_b32 %0, m0\n\ts_mov_b32 m0, %5\n\ts_nop 0\n\tglobal_load_lds_dwordx4 %1, off\n\tglobal_load_lds_dwordx4 %2, off offset:1024\n\tglobal_load_lds_dwordx4 %3, off offset:2048\n\tglobal_load_lds_dwordx4 %4, off offset:3072\n\ts_mov_b32 m0, %0"
                 : "=&s"(keep) : "v"(p0), "v"(p1), "v"(p2), "v"(p3), "s"(lds_dst) : "memory"); }
__device__ __forceinline__ void bg_convert(const BgItem& it, LAS const float* sc, int lane) {
    asm volatile("s_waitcnt vmcnt(0)" ::: "memory");
    const int n = lane & 31, kh = lane >> 5; float v[16];
#pragma unroll
    for (int i = 0; i < 16; ++i) v[i] = sc[(16 * kh + i) * 32 + n];
    typedef short v2s_ __attribute__((ext_vector_type(2)));
    const float rsc = 1.0f / FP8_W_MUL;
    u32x4 a; unsigned aw[4];
#pragma unroll
    for (int q = 0; q < 4; ++q) { v2s_ w = {0, 0};
        w = __builtin_amdgcn_cvt_scalef32_pk_fp8_f32(w, v[4 * q], v[4 * q + 1], rsc, false);
        w = __builtin_amdgcn_cvt_scalef32_pk_fp8_f32(w, v[4 * q + 2], v[4 * q + 3], rsc, true);
        aw[q] = __builtin_bit_cast(unsigned, w); }
    a.x = aw[0]; a.y = aw[1]; a.z = aw[2]; a.w = aw[3];
    *(u32x4*)(it.dst + (size_t)n * 1024 + 16 * kh) = a;
}
#define ATT_CLOSE(C) do { if ((C) == 8) { ATT_WAIT_BAR(8); } else if ((C) == 6) { ATT_WAIT_BAR(6); } else if ((C) == 5) { ATT_WAIT_BAR(5); } else if ((C) == 4) { ATT_WAIT_BAR(4); } else if ((C) == 3) { ATT_WAIT_BAR(3); } else { ATT_WAIT_BAR(2); } } while (0)

template <int THRL, bool FAST>
__device__ __forceinline__ void attn_unit(int b, int h, int qb, const bf16_t* proj, const bf16_t* kt, const bf16_t* vt, const unsigned char* q8g, bf16_t* oproj, char* shm, float lam, const float* __restrict__ subw, const BgCtx bg, int bgbase, int bgstride, const unsigned* kmax2_bits, int wid_in) {
    const int wid = __builtin_amdgcn_readfirstlane(wid_in), lane = lane_opaque(), r32 = lane & 31, hi = lane >> 5;
    const int qg = wid & 3, comp = wid >> 2;
    const long rowbase = (long)b * SEQ; const int q0 = qb * 128;
    const unsigned lds0 = (unsigned)(uintptr_t)shm;
    const lds_cptr shm3 = (lds_cptr)shm;
    LAS float* wsf = (LAS float*)(shm3 + WSF_OFF) + wid * 64;
    const bf16_t* ksrc = kt + (size_t)((b * 8 + h) * NTB) * 8192 + wid * 512 + lane * 8;
    const bf16_t* vsrc = vt + (size_t)((b * 8 + h) * NTB) * 8192 + wid * 512 + lane * 8;
    const unsigned kdst = lds0 + LDS_K + wid * 1024, vdst = lds0 + LDS_V + wid * 1024;
#define DMA_K(t, slot) do { const bf16_t* _s = ksrc + (size_t)(t) * 8192; glds16(_s, (unsigned)__builtin_amdgcn_readfirstlane(kdst + (slot))); glds16(_s + 4096, (unsigned)__builtin_amdgcn_readfirstlane(kdst + (slot) + 8192)); } while (0)
#define DMA_V(t, slot) do { const bf16_t* _s = vsrc + (size_t)(t) * 8192; glds16(_s, (unsigned)__builtin_amdgcn_readfirstlane(vdst + (slot))); glds16(_s + 4096, (unsigned)__builtin_amdgcn_readfirstlane(vdst + (slot) + 8192)); } while (0)
#define DMA_K16(t, slot) do { const bf16_t* _s = kt + (size_t)((b * 8 + h) * NTB + (t)) * 8192 + qg * 2048; const unsigned _d = lds0 + LDS_K + (slot) + qg * 4096; \
        glds16x4s(_s, (unsigned)lane * 16u, (unsigned)__builtin_amdgcn_readfirstlane(_d)); } while (0)
#define DMA_V16(t, slot) do { const bf16_t* _s = vt + (size_t)((b * 8 + h) * NTB + (t)) * 8192 + qg * 2048; const unsigned _d = lds0 + LDS_V + (slot) + qg * 4096; \
        glds16x4s(_s, (unsigned)lane * 16u, (unsigned)__builtin_amdgcn_readfirstlane(_d)); } while (0)
    const lds_cptr kp0 = shm3 + LDS_K + comp * 4096 + hi * 1024 + r32 * 32;
    const lds_cptr vp0 = shm3 + LDS_V + hi * 1024 + r32 * 32;
    DMA_K(0, 0); DMA_V(0, 0); DMA_K(1, SLOTB); DMA_V(1, SLOTB);
    v8i qr;
    { const unsigned char* qp = q8g + (size_t)(rowbase + q0 + qg * 32 + r32) * D + h * 128 + comp * 64 + 32 * hi;
      qr = __builtin_shufflevector(*(const v4i*)qp, *(const v4i*)(qp + 16), 0, 1, 2, 3, 4, 5, 6, 7); }
    AttnState st;
    st.o0 = f32x16{}; st.o1 = f32x16{}; st.o2 = f32x16{}; st.o3 = f32x16{};
    st.negm = f32x16{}; st.p0 = f32x16{}; st.p1 = f32x16{}; st.p2 = f32x16{}; st.p3 = f32x16{}; st.lacc = f32x16{}; st.pa = v8i{}; { int o1 = 0x38383838; asm volatile("" : "+v"(o1)); st.ones = (v8i){o1, o1, o1, o1, o1, o1, o1, o1}; asm volatile("" : "+v"(st.ones)); } st.mhat = 0.f; st.l_reg = 0.f;
    int sm1 = 2 * SLOTB, s0 = 0, sp1 = SLOTB;
#define ATT_ROT() do { const int _s = sm1; sm1 = s0; s0 = sp1; sp1 = _s; } while (0)
    v8i kf[4];
    const int grp = 4;
    BgItem bgi; bool bgp = false; const unsigned bgl = lds0 + BG_LDS + wid * 4096; LAS const float* bgs = (LAS const float*)(shm3 + BG_LDS + wid * 4096);
#define ATT_BG(t, CLOSE) do { CLOSE = grp; if (((t) & 3) == 1 && bgp) { bg_convert(bgi, bgs, lane); bgp = false; CLOSE = grp + 1; } } while (0)
#define ATT_BG_ISSUE(t, CLOSE) do { if (((t) & 3) == 0) { bgp = bg_decode(bg, bgbase + ((((t) >> 2) - 1) * 8 + wid) * bgstride, bgi); if (bgp) { bg_issue(bgi, (unsigned)__builtin_amdgcn_readfirstlane(bgl), lane); CLOSE = grp + 4; } } } while (0)
    if (comp == 0) {
        ATT_WAIT_BAR(0);
        attn_kload(kf, kp0 + s0);
        attn_s1<THRL, FAST>(st, kf, qr, true, r32, hi);
        DMA_K16(2, sm1);
        ATT_WAIT_BAR(4);
        attn_s2<FAST>(st, vp0 + s0, kf, kp0 + sp1);
        ATT_ROT();
#pragma unroll 1
        for (int t = 1; t < NTB; ++t) {
            const int tn = (t + 2 < NTB) ? t + 2 : NTB - 1; int cl;
            ATT_WAIT_BAR(8);
            attn_s1<THRL, FAST>(st, kf, qr, false, r32, hi);
            ATT_BG(t, cl);
            DMA_K16(tn, sm1);
            ATT_BG_ISSUE(t, cl);
            ATT_CLOSE(cl);
            attn_s2<FAST>(st, vp0 + s0, kf, kp0 + sp1);
            ATT_ROT();
        }
        ATT_WAIT_BAR(4);
    } else {
        ATT_WAIT_BAR(0);
        ATT_WAIT_BAR(8);
        attn_kload(kf, kp0 + s0);
        attn_s1<THRL, FAST>(st, kf, qr, true, r32, hi);
        DMA_V16(2, sm1);
        ATT_ROT();
        int cl = 4;
#pragma unroll 1
        for (int t = 1; t < NTB; ++t) {
            const int tn = (t + 2 < NTB) ? t + 2 : NTB - 1;
            ATT_CLOSE(cl);
            attn_s2<FAST>(st, vp0 + sm1, kf, kp0 + s0);
            ATT_WAIT_BAR(8);
            attn_s1<THRL, FAST>(st, kf, qr, false, r32, hi);
            ATT_BG(t, cl);
            DMA_V16(tn, sm1);
            ATT_BG_ISSUE(t, cl);
            ATT_ROT();
        }
        ATT_CLOSE(cl);
        attn_s2<FAST>(st, vp0 + sm1, kf, kp0 + s0);
    }
#undef ATT_BG
#undef ATT_BG_ISSUE
#undef ATT_ROT
    float l_reg = st.l_reg;
    if constexpr (FAST) { asm volatile("s_nop 15\n\ts_nop 15" ::: "memory"); l_reg = st.lacc[0]; }
    else { auto rr = __builtin_amdgcn_permlane32_swap(__float_as_uint(l_reg), __float_as_uint(l_reg), false, false); l_reg = __uint_as_float(rr[0]) + __uint_as_float(rr[1]); }
    const float coef = (comp == 0 ? 1.0f : -lam) / l_reg;
    ATT_WAIT_BAR(0);
    LAS float* X = (LAS float*)shm3;
    LAS float* Y = X + 4 * 2 * 32 * 64;
    f32x16 m0, m1;
    { LAS float* xw = X + ((qg * 2 + comp) * 32) * 64 + lane;
      if (comp == 0) {
#pragma unroll
          for (int r = 0; r < 16; ++r) { xw[r * 64] = st.o2[r] * coef; xw[(16 + r) * 64] = st.o3[r] * coef; }
          m0 = st.o0 * coef; m1 = st.o1 * coef;
      } else {
#pragma unroll
          for (int r = 0; r < 16; ++r) { xw[r * 64] = st.o0[r] * coef; xw[(16 + r) * 64] = st.o1[r] * coef; }
          m0 = st.o2 * coef; m1 = st.o3 * coef;
      } }
    ATT_WAIT_BAR(0);
    float ss = 0.f;
    { const LAS float* xr = X + ((qg * 2 + (1 - comp)) * 32) * 64 + lane;
#pragma unroll
      for (int r = 0; r < 16; ++r) { m0[r] += xr[r * 64]; m1[r] += xr[(16 + r) * 64]; ss += m0[r] * m0[r] + m1[r] * m1[r]; } }
    { auto rr = __builtin_amdgcn_permlane32_swap(__float_as_uint(ss), __float_as_uint(ss), false, false); ss = __uint_as_float(rr[0]) + __uint_as_float(rr[1]); }
    Y[(qg * 2 + comp) * 64 + lane] = ss;
    ATT_WAIT_BAR(0);
    ss += Y[(qg * 2 + (1 - comp)) * 64 + lane];
    { const float rstd = (1.0f - LAMBDA_INIT) / sqrtf(ss * (1.0f / 128.0f) + SUBLN_EPS);
      bf16_t* op = oproj + (rowbase + q0 + qg * 32 + r32) * D + h * 128 + 64 * comp + 4 * hi;
      const float* sw = subw + 64 * comp + 4 * hi;
#pragma unroll
      for (int g4 = 0; g4 < 4; ++g4) { const f32x4 w0 = *(const f32x4*)(sw + 8 * g4), w1 = *(const f32x4*)(sw + 32 + 8 * g4);
          u32x2 a, c2;
          a.x = cvt_pk_bf16(m0[4 * g4] * rstd * w0[0], m0[4 * g4 + 1] * rstd * w0[1]); a.y = cvt_pk_bf16(m0[4 * g4 + 2] * rstd * w0[2], m0[4 * g4 + 3] * rstd * w0[3]);
          c2.x = cvt_pk_bf16(m1[4 * g4] * rstd * w1[0], m1[4 * g4 + 1] * rstd * w1[1]); c2.y = cvt_pk_bf16(m1[4 * g4 + 2] * rstd * w1[2], m1[4 * g4 + 3] * rstd * w1[3]);
          *(u32x2*)(op + 8 * g4) = a; *(u32x2*)(op + 32 + 8 * g4) = c2; } }
    ATT_WAIT_BAR(0);
#undef DMA_K
#undef DMA_V
#undef DMA_K16
#undef DMA_V16
}
}

#define XB_TMO      128
#define XB_XCNT(j)  (256  + 64 * (j))
#define XB_XSUB(j)  (1280 + 64 * (j))
#define XB_XGEN(j)  (2304 + 64 * (j))
#define XB_TOP      3328
#define XB_TOPGEN   3392
#define XB_XMAP(k)  (3456 + (k))
#define XCD_BAR_WORDS 3456
#define XB_SPIN_CAP (1u << 18)
__device__ __forceinline__ unsigned xb_ld(unsigned* p)              { return __hip_atomic_load(p, __ATOMIC_RELAXED, __HIP_MEMORY_SCOPE_AGENT); }
__device__ __forceinline__ unsigned xb_add(unsigned* p, unsigned v) { return __hip_atomic_fetch_add(p, v, __ATOMIC_RELAXED, __HIP_MEMORY_SCOPE_AGENT); }
__device__ __forceinline__ unsigned xb_xcc_id() { return (unsigned)__builtin_amdgcn_s_getreg((3 << 11) | 20) & 0xFu; }
#define XB_SPIN(cond, bar) do { unsigned _sp = 0; while (cond) { __builtin_amdgcn_s_sleep(1); \
    if ((++_sp & 255u) == 0u) { if (xb_ld(&(bar)[XB_TMO])) break; if (_sp > XB_SPIN_CAP) { atomicAdd(&(bar)[XB_TMO], 1u); break; } } } } while (0)
struct XcdBarrier { unsigned* bar; unsigned x; volatile LAS unsigned* st; int wave; };
__device__ __forceinline__ XcdBarrier xcd_barrier_post(unsigned* bar, volatile LAS unsigned* st) {
    XcdBarrier b; b.bar = bar; b.x = xb_xcc_id(); b.st = st; b.wave = 0;
    if (threadIdx.x == 0) (void)xb_add(&bar[XB_XCNT(b.x)], 1u);
    return b;
}
__device__ __forceinline__ void xcd_barrier_complete(unsigned* bar, unsigned x, unsigned& nloc, unsigned& nx) {
    const unsigned G = gridDim.x * gridDim.y * gridDim.z;
    unsigned sum, cnt, mine, sp = 0u;
    for (;;) {
        sum = 0u; cnt = 0u; mine = 0u;
#pragma unroll
        for (unsigned j = 0; j < 16; ++j) { const unsigned c = xb_ld(&bar[XB_XCNT(j)]); sum += c; cnt += (c > 0u) ? 1u : 0u; mine = (j == x) ? c : mine; }
        if (sum == G) break;
        __builtin_amdgcn_s_sleep(1);
        if ((++sp & 255u) == 0u) { if (xb_ld(&bar[XB_TMO])) break; if (sp > XB_SPIN_CAP) { atomicAdd(&bar[XB_TMO], 1u); break; } }
    }
    nloc = mine > 0u ? mine : 1u; nx = cnt > 0u ? cnt : 1u;
}
__device__ __forceinline__ void xcd_barrier(const XcdBarrier& b, bool local = false) {
    asm volatile("s_waitcnt vmcnt(0)" ::: "memory");
    __syncthreads();
    if (b.wave == 0 && lane_opaque() == 0) {
        unsigned* bar = b.bar;
        __builtin_amdgcn_s_waitcnt(0);
        asm volatile("buffer_inv sc1" ::: "memory");
        unsigned nloc = b.st[0], nx = b.st[1];
        if (nloc == 0u) { xcd_barrier_complete(bar, b.x, nloc, nx); b.st[0] = nloc; b.st[1] = nx; }
        const unsigned old = xb_add(&bar[XB_XSUB(b.x)], 1u);
        const unsigned gen = old / nloc;
        if (old + 1u == (gen + 1u) * nloc) {
            if (!local) {
            __builtin_amdgcn_fence(__ATOMIC_RELEASE, "agent");
            asm volatile("s_waitcnt vmcnt(0)" ::: "memory");
            const unsigned og = xb_add(&bar[XB_TOP], 1u);
            const unsigned tg = og / nx;
            if (og + 1u == (tg + 1u) * nx) xb_add(&bar[XB_TOPGEN], 1u);
            else XB_SPIN(xb_ld(&bar[XB_TOPGEN]) == tg, bar);
            }
            xb_add(&bar[XB_XGEN(b.x)], 1u);
            asm volatile("s_waitcnt vmcnt(0)" ::: "memory");
        } else {
            XB_SPIN(xb_ld(&bar[XB_XGEN(b.x)]) == gen, bar);
            asm volatile("s_waitcnt vmcnt(0)" ::: "memory");
        }
    }
    __syncthreads();
}

constexpr int NWAVES = 8;
constexpr int N_PHASES = 11;
struct Frame {
    LAS unsigned char* lds;
    volatile LAS unsigned* MISC;
    gu32* ctl;
    int tid, lane, wave, vcu, G;
    unsigned char* ws;
    const float *x, *c, *w_ada, *b_ada, *norm1_w, *w_in, *q_norm_w, *k_norm_w, *lq1, *lk1, *lq2, *lk2, *subln_w, *w_attn_o, *conv_w, *w_conv_o, *w_out, *norm2_w,
                *w_router, *b_router, *w_gate_up, *b_gate_up, *w_down, *b_down;
    float* out;
};

__device__ __forceinline__ void p0_transpose_item(const float* W, int K, int N, bf16_t* WT, LAS float* scr, int item, int lane) {
    const int nblk = N / 32, kb = item / nblk, nb = item % nblk, k0 = 64 * kb, n0 = 32 * nb;
#pragma unroll 8
    for (int i = 0; i < 32; ++i) { const int kk = 2 * i + (lane >> 5); scr[kk * 33 + (lane & 31)] = W[(size_t)(k0 + kk) * N + n0 + (lane & 31)]; }
    LDS_WAIT(); asm volatile("" ::: "memory");
    const int c = lane & 7;
#pragma unroll
    for (int j = 0; j < 4; ++j) { const int n = (lane >> 3) + 8 * j; const LAS float* s = scr + (8 * c) * 33 + n;
        u32x4 o; o.x = pk2(s[0 * 33], s[1 * 33]); o.y = pk2(s[2 * 33], s[3 * 33]); o.z = pk2(s[4 * 33], s[5 * 33]); o.w = pk2(s[6 * 33], s[7 * 33]);
        *(GAS u32x4*)(WT + (size_t)(n0 + n) * K + k0 + 8 * c) = o; }
    LDS_WAIT(); asm volatile("" ::: "memory");
}

__device__ __forceinline__ void p0_transpose_item8(const float* W, int K, int N, unsigned char* WT, int nrow0, LAS float* scr, int item, int lane) {
    const int nblk = N / 32, kb = item / nblk, nb = item % nblk, k0 = 64 * kb, n0 = 32 * nb;
#pragma unroll 8
    for (int i = 0; i < 32; ++i) { const int kk = 2 * i + (lane >> 5); scr[kk * 33 + (lane & 31)] = W[(size_t)(k0 + kk) * N + n0 + (lane & 31)]; }
    LDS_WAIT(); asm volatile("" ::: "memory");
    const int c = lane & 7;
#pragma unroll
    for (int j = 0; j < 4; ++j) { const int n = (lane >> 3) + 8 * j; const LAS float* s = scr + (8 * c) * 33 + n;
        u32x2 o; o.x = cvt4_fp8(s[0 * 33] * FP8_W_MUL, s[1 * 33] * FP8_W_MUL, s[2 * 33] * FP8_W_MUL, s[3 * 33] * FP8_W_MUL); o.y = cvt4_fp8(s[4 * 33] * FP8_W_MUL, s[5 * 33] * FP8_W_MUL, s[6 * 33] * FP8_W_MUL, s[7 * 33] * FP8_W_MUL);
        *(GAS u32x2*)(WT + (size_t)(nrow0 + n0 + n) * K + k0 + 8 * c) = o; }
    LDS_WAIT(); asm volatile("" ::: "memory");
}
__device__ __forceinline__ void phase_p0(Frame& F) {
    LAS float* scr = (LAS float*)(F.lds + F.wave * 16384);
    const int gw = F.vcu * NWAVES + F.wave, NGW = F.G * NWAVES;
    for (int it = gw; it < 96 * 16; it += NGW) {
        const int cg = it % 96, ks = it / 96, col = cg * 64 + F.lane;
        float a0 = 0.f, a1 = 0.f;
#pragma unroll 8
        for (int kk = 0; kk < 64; ++kk) { const int k = ks * 64 + kk; const float w = F.w_ada[(size_t)k * 6144 + col];
            const float c0 = F.c[k], c1 = F.c[D + k];
            a0 += (c0 * sigmoidf_fast(c0)) * w; a1 += (c1 * sigmoidf_fast(c1)) * w; }
        float* mp = (float*)(F.ws + WS_MODP);
        mp[(size_t)(ks * 2 + 0) * 6144 + col] = a0; mp[(size_t)(ks * 2 + 1) * 6144 + col] = a1;
    }
    { f32x2* cs = (f32x2*)(F.ws + WS_ROPE); const int gt = F.vcu * 512 + F.tid, NGT = F.G * 512;
      for (int idx = gt; idx < SEQ * 32; idx += NGT) { const int pos = idx >> 5, i = idx & 31;
          const float invf = exp2f(-(float)i * (13.287712379549449f / 32.0f));
          const float ang = (float)pos * invf;
          const double rev = (double)ang * 0.15915494309189535; const double fr = rev - floor(rev);
          const float frf = (float)fr;
          cs[idx] = (f32x2){__builtin_amdgcn_cosf(frf), __builtin_amdgcn_sinf(frf)}; } }
    constexpr int I_IN = (D / 64) * (INW / 32), I_SQ = (D / 64) * (D / 32), I_GU = (D / 64) * (2 * DFF / 32), I_DN = (DFF / 64) * (D / 32);
    constexpr int NITEMS = I_IN + 3 * I_SQ;
    for (int it = gw; it < NITEMS; it += NGW) {
        int r = it;
        if (r < I_IN) { const int nb = r % (INW / 32), n0 = 32 * nb;
            constexpr int C_B16 = C_CB + 1024 * CONV_FP8_PLANES;
            if (n0 >= C_B16 && n0 < C_GA) p0_transpose_item(F.w_in, D, INW, (bf16_t*)(F.ws + WS_WIN) - (size_t)C_B16 * D, scr, r, F.lane);
            else { const int dst = n0 < C_V ? 256 * (n0 >> 8) + 128 * ((n0 >> 5) & 1) + 32 * ((n0 >> 6) & 3)
                                           : (n0 < C_B16 ? n0 : n0 - (C_GA - C_B16));
                p0_transpose_item8(F.w_in, D, INW, F.ws + WS_WIN + 8 * MiB, dst - n0, scr, r, F.lane); }
            continue; } r -= I_IN;
        if (r < I_SQ) { p0_transpose_item(F.w_attn_o, D, D, (bf16_t*)(F.ws + WS_WAO), scr, r, F.lane); continue; } r -= I_SQ;
        if (r < I_SQ) { p0_transpose_item(F.w_conv_o, D, D, (bf16_t*)(F.ws + WS_WCO), scr, r, F.lane); continue; } r -= I_SQ;
        if (r < I_SQ) { p0_transpose_item(F.w_out, D, D, (bf16_t*)(F.ws + WS_WOUT), scr, r, F.lane); continue; } r -= I_SQ;
        if (r < NE * I_GU) { const int e = r / I_GU, ii = r % I_GU;
            p0_transpose_item(F.w_gate_up + (size_t)e * D * 2 * DFF, D, 2 * DFF, (bf16_t*)(F.ws + WS_WGU) + (size_t)e * 2 * DFF * D, scr, ii, F.lane); continue; } r -= NE * I_GU;
        { const int e = r / I_DN, ii = r % I_DN;
            p0_transpose_item(F.w_down + (size_t)e * DFF * D, DFF, D, (bf16_t*)(F.ws + WS_WD) + (size_t)e * D * DFF, scr, ii, F.lane); }
    }
}

__device__ __forceinline__ void phase_p1(Frame& F) {
    const float* mp = (const float*)(F.ws + WS_MODP);
    const int v = F.vcu, b = v >> 7;
    LAS float* a1 = (LAS float*)F.lds; LAS float* s1 = a1 + D;
    for (int col = F.tid; col < D; col += 512) {
        float sh = F.b_ada[col], sc = F.b_ada[D + col];
#pragma unroll
        for (int ks = 0; ks < 16; ++ks) { sh += mp[(size_t)(ks * 2 + b) * 6144 + col]; sc += mp[(size_t)(ks * 2 + b) * 6144 + D + col]; }
        a1[col] = F.norm1_w[col] * (1.0f + sc); s1[col] = sh;
    }
    if (F.tid < 48) { const int f = 48 * v + F.tid, bb = f / 6144, cc = f % 6144; float m = F.b_ada[cc];
#pragma unroll
        for (int ks = 0; ks < 16; ++ks) m += mp[(size_t)(ks * 2 + bb) * 6144 + cc];
        ((float*)(F.ws + WS_MOD))[f] = m; }
    __syncthreads();
    f32x4 av[4], sv[4];
#pragma unroll
    for (int j = 0; j < 4; ++j) { av[j] = *(const LAS f32x4*)(a1 + 4 * F.lane + 256 * j); sv[j] = *(const LAS f32x4*)(s1 + 4 * F.lane + 256 * j); }
    bf16_t* XN = (bf16_t*)(F.ws + WS_XN);
#pragma unroll 4
    for (int i = 0; i < 8; ++i) { const int row = 64 * v + 8 * F.wave + i;
        const GAS f32x4* xr = (const GAS f32x4*)(F.x + (size_t)row * D) + F.lane;
        f32x4 xv[4]; float s = 0.f;
#pragma unroll
        for (int j = 0; j < 4; ++j) { xv[j] = xr[64 * j]; s += (xv[j].x * xv[j].x + xv[j].y * xv[j].y) + (xv[j].z * xv[j].z + xv[j].w * xv[j].w); }
        const float rstd = 1.0f / sqrtf(wave_sum(s) * (1.0f / D) + RMS_EPS);
        GAS unsigned long long* o8 = (GAS unsigned long long*)(XN + (size_t)row * D) + F.lane;
        GAS unsigned* o4 = (GAS unsigned*)(F.ws + WS_XN8 + (size_t)row * D) + F.lane;
#pragma unroll
        for (int j = 0; j < 4; ++j) { const f32x4 hh = xv[j] * rstd * av[j] + sv[j];
            o8[64 * j] = (unsigned long long)pk2(hh.x, hh.y) | ((unsigned long long)pk2(hh.z, hh.w) << 32);
            o4[64 * j] = cvt4_fp8(hh.x, hh.y, hh.z, hh.w); } }
    __syncthreads();
}

__device__ __forceinline__ void conv_loadu(const bf16_t* proj, int row, int c0, float (&u)[8]) {
    const u32x4 a = *(const u32x4*)(proj + PL(C_CC) + (size_t)row * D + c0), c = *(const u32x4*)(proj + PL(C_CX) + (size_t)row * D + c0);
    u[0] = bflo(a.x) * bflo(c.x); u[1] = bfhi(a.x) * bfhi(c.x); u[2] = bflo(a.y) * bflo(c.y); u[3] = bfhi(a.y) * bfhi(c.y);
    u[4] = bflo(a.z) * bflo(c.z); u[5] = bfhi(a.z) * bfhi(c.z); u[6] = bflo(a.w) * bflo(c.w); u[7] = bfhi(a.w) * bfhi(c.w);
}
__device__ __forceinline__ void phase_l1(Frame& F) {
    bf16_t* proj = (bf16_t*)(F.ws + WS_PROJ);
    const f32x2* cs = (const f32x2*)(F.ws + WS_ROPE);
    const int lane = F.lane, sub = lane & 3, grp = lane >> 2;
    const int r0 = 64 * F.vcu + 8 * F.wave;
#pragma unroll 1
    for (int ch = 0; ch < 2; ++ch) { const int c0 = 512 * ch + 8 * lane;
        float w0[8], w1[8], w2[8];
#pragma unroll
        for (int j = 0; j < 8; ++j) { w0[j] = F.conv_w[c0 + j]; w1[j] = F.conv_w[D + c0 + j]; w2[j] = F.conv_w[2 * D + c0 + j]; }
        float up[8], uc[8], un[8];
        if ((r0 & (SEQ - 1)) != 0) conv_loadu(proj, r0 - 1, c0, up); else {
#pragma unroll
            for (int j = 0; j < 8; ++j) up[j] = 0.f; }
        conv_loadu(proj, r0, c0, uc);
#pragma unroll 4
        for (int i = 0; i < 8; ++i) { const int row = r0 + i;
            if (((row + 1) & (SEQ - 1)) != 0) conv_loadu(proj, row + 1, c0, un); else {
#pragma unroll
                for (int j = 0; j < 8; ++j) un[j] = 0.f; }
            bf16_t* p = proj + PL(C_CB) + (size_t)row * D + c0;
            const u32x4 bv = *(const u32x4*)p;
            const float cbv[8] = {bflo(bv.x), bfhi(bv.x), bflo(bv.y), bfhi(bv.y), bflo(bv.z), bfhi(bv.z), bflo(bv.w), bfhi(bv.w)};
            float z[8];
#pragma unroll
            for (int j = 0; j < 8; ++j) { z[j] = cbv[j] * (w0[j] * up[j] + w1[j] * uc[j] + w2[j] * un[j]); up[j] = uc[j]; uc[j] = un[j]; }
            u32x4 w; w.x = pk2(z[0], z[1]); w.y = pk2(z[2], z[3]); w.z = pk2(z[4], z[5]); w.w = pk2(z[6], z[7]);
            *(u32x4*)((bf16_t*)(F.ws + WS_Z) + (size_t)row * D + c0) = w; }
    }
}

struct InProjOrder {
    pg8::StaticOrder so;
    __device__ bool next(int i, pg8::Unit& u) const { return so.next(i, u); }
    __device__ __forceinline__ int arow(const pg8::Unit& u, int r) const {
        if (u.pn >= 8 && u.pn < 12) { const int ai = (r >> 7) & 1, wr = (r >> 6) & 1, m = (r >> 4) & 3, fr = r & 15;
            r = 64 * (2 * wr + (fr >> 3)) + 16 * ((fr >> 1) & 3) + 8 * ai + 4 * (fr & 1) + m; }
        return u.pm * pg8::BM + r; }
    __device__ __forceinline__ int acol(const pg8::Unit&) const { return 0; }
};
struct ChainOrder {
    pg8::StaticOrder so;
    __device__ bool next(int i, pg8::Unit& u) const { if (i >= 2) return false; const bool ok = so.next(0, u); u.e = 1 - i; return ok; }
    __device__ __forceinline__ int arow(const pg8::Unit& u, int r) const { return u.pm * pg8::BM + r; }
    __device__ __forceinline__ int acol(const pg8::Unit& u) const { return u.e ? 0 : (int)((WS_ON - WS_Z) / 2); }
};
__device__ __forceinline__ void moe_tables(Frame& F) {
    LAS int* tb = (LAS int*)(F.lds + TBL_OFF);
    if (F.wave == 0) {
        const int e = F.lane & 31; int c = (int)__hip_atomic_load(F.ctl + CW_CNT + e, RLX_AGENT); c = c > ECAP ? ECAP : c;
        const int nte = (c + 255) >> 8; int inc = nte;
#pragma unroll
        for (int o = 1; o < 32; o <<= 1) { const int v = __shfl_up(inc, o, 32); if (e >= o) inc += v; }
        const int base = inc - nte;
        if (F.lane < NE) { tb[e] = c; tb[32 + e] = base;
            for (int t = 0; t < nte; ++t) { if (base + t < MAXTILES) { tb[128 + base + t] = e; tb[448 + base + t] = 256 * t; } }
            if (e == NE - 1) { tb[64] = inc; tb[65] = inc > MAXTILES ? MAXTILES : inc; } } }
    __syncthreads();
}
struct MoeOrder {
    int nunits, npn, c; const LAS int* tb; const int* list; bool gather;
    __device__ bool next(int i, pg8::Unit& u) const {
        const int x = c & 7, j = c >> 3, T = nunits / npn, rm = npn == 8 ? 8 : 4;
        if (i < rm) { if (npn == 8) { u.pm = (i >> 1) * 64 + x * 8 + (i & 1) * 4 + (j >> 3); u.pn = j & 7; } else { u.pm = i * 64 + x * 8 + (j >> 2); u.pn = j & 3; } }
        else { const int k = i - rm, per = npn == 8 ? 3 : 2;
            if ((j >> per) >= 2) return false;
            u.pm = 256 + 16 * k + 2 * x + (j >> per); u.pn = j & (npn - 1); }
        if (u.pm >= T) return false;
        u.e = tb[128 + u.pm]; return true;
    }
    __device__ __forceinline__ int arow(const pg8::Unit& u, int r) const {
        if (!gather) return u.pm * 256 + r;
        const int jl = tb[448 + u.pm] + r; const int cnt = tb[u.e];
        return list[(size_t)u.e * ECAP + (jl < cnt ? jl : 0)];
    }
    __device__ __forceinline__ int acol(const pg8::Unit&) const { return 0; }
};

__device__ __forceinline__ void phase_r1(Frame& F) {
    const float* mod = (const float*)(F.ws + WS_MOD);
    const int v = F.vcu, b = v >> 7, lane = F.lane, w = F.wave;
    constexpr int TROW = 1028;
    LAS float* tile = (LAS float*)F.lds;
    LAS float* part = (LAS float*)F.lds;
    LAS float* lg = (LAS float*)(F.lds + 40960);
    LAS int* hist = (LAS int*)(F.lds + TBL_OFF);
    LAS int* sel = (LAS int*)(F.lds + TBL_OFF + 512);
    if (F.tid < 64) hist[F.tid] = 0;
    f32x4 av[4], sv[4];
#pragma unroll
    for (int j = 0; j < 4; ++j) { const int col = 4 * lane + 256 * j;
        const f32x4 nw = *(const f32x4*)(F.norm2_w + col), sc = *(const f32x4*)(mod + b * 6144 + 4 * D + col);
        av[j] = nw * (1.0f + sc); sv[j] = *(const f32x4*)(mod + b * 6144 + 3 * D + col); }
    bf16_t* H2 = (bf16_t*)(F.ws + WS_XN);
    const float* x1 = F.out;
    float bwr[16][4];
#pragma unroll
    for (int j = 0; j < 16; ++j)
#pragma unroll
        for (int i = 0; i < 4; ++i) bwr[j][i] = F.w_router[(size_t)(128 * w + 8 * j + 4 * (lane >> 5) + i) * NE + (lane & 31)];
    for (int tl = 0; tl < 2; ++tl) {
        __syncthreads();
#pragma unroll
        for (int i = 0; i < 4; ++i) { const int lr = 4 * w + i, row = 64 * v + 32 * tl + lr;
            const GAS f32x4* xr = (const GAS f32x4*)(x1 + (size_t)row * D) + lane;
            f32x4 xv[4]; float s = 0.f;
#pragma unroll
            for (int j = 0; j < 4; ++j) { xv[j] = xr[64 * j]; s += (xv[j].x * xv[j].x + xv[j].y * xv[j].y) + (xv[j].z * xv[j].z + xv[j].w * xv[j].w); }
            const float rstd = 1.0f / sqrtf(wave_sum(s) * (1.0f / D) + RMS_EPS);
            GAS unsigned* o4 = (GAS unsigned*)((unsigned char*)H2 + (size_t)row * D) + lane;
#pragma unroll
            for (int j = 0; j < 4; ++j) { const f32x4 hh = xv[j] * rstd * av[j] + sv[j];
                o4[64 * j] = cvt4_fp8(hh.x, hh.y, hh.z, hh.w);
                *(LAS f32x4*)(tile + lr * TROW + 4 * lane + 256 * j) = hh; } }
        __syncthreads();
        f32x16 acc = f32x16{};
        { const int r32 = lane & 31, hi = lane >> 5;
#pragma unroll
          for (int j = 0; j < 16; ++j) { const int k0 = 128 * w + 8 * j + 4 * hi;
              const f32x4 a4 = *(const LAS f32x4*)(tile + r32 * TROW + k0);
#pragma unroll
              for (int i = 0; i < 4; ++i) acc = __builtin_amdgcn_mfma_f32_32x32x2f32(a4[i], bwr[j][i], acc, 0, 0, 0); }
          __syncthreads();
#pragma unroll
          for (int r = 0; r < 16; ++r) part[(w * 32 + attn::crow(r, hi)) * 33 + r32] = acc[r]; }
        __syncthreads();
        for (int idx = F.tid; idx < 1024; idx += 512) { const int row = idx >> 5, e = idx & 31; float s = F.b_router[e];
#pragma unroll
            for (int ww = 0; ww < 8; ++ww) s += part[(ww * 32 + row) * 33 + e];
            lg[row * 33 + e] = s; }
        __syncthreads();
        if (F.tid < 32) { const int row = F.tid; float lv[32];
#pragma unroll
            for (int e = 0; e < 32; ++e) lv[e] = lg[row * 33 + e];
            int se[4]; float svv[4];
#pragma unroll
            for (int k = 0; k < 4; ++k) { float best = -INFINITY; int bi = 0;
#pragma unroll
                for (int e = 0; e < 32; ++e) { const bool better = lv[e] > best; best = better ? lv[e] : best; bi = better ? e : bi; }
                se[k] = bi; svv[k] = best;
#pragma unroll
                for (int e = 0; e < 32; ++e) lv[e] = (e == bi) ? -INFINITY : lv[e]; }
            float ex[4], den = 0.f;
#pragma unroll
            for (int k = 0; k < 4; ++k) { ex[k] = __expf(svv[k] - svv[0]); den += ex[k]; }
#pragma unroll
            for (int k = 0; k < 4; ++k) { const int pos = __hip_atomic_fetch_add(&hist[se[k]], 1, __ATOMIC_RELAXED, __HIP_MEMORY_SCOPE_WORKGROUP); const int li = (32 * tl + row) * 4 + k;
                sel[li] = se[k]; sel[256 + li] = pos; sel[512 + li] = __float_as_int(ex[k] / den); } }
    }
    __syncthreads();
    if (F.tid < NE) { const int n = hist[F.tid]; hist[32 + F.tid] = n ? (int)__hip_atomic_fetch_add(F.ctl + CW_CNT + F.tid, (unsigned)n, RLX_AGENT) : 0; }
    __syncthreads();
    if (F.tid < 256) { const int li = F.tid, e = sel[li], idx = hist[32 + e] + sel[256 + li]; const int tok = 64 * v + (li >> 2);
        int* list = (int*)(F.ws + WS_LIST); int* pair = (int*)(F.ws + WS_PAIR); float* pw = (float*)(F.ws + WS_PAIR + 512 * 1024);
        if (idx < ECAP) list[(size_t)e * ECAP + idx] = tok;
        pair[tok * 4 + (li & 3)] = (e << 20) | idx; pw[tok * 4 + (li & 3)] = __int_as_float(sel[512 + li]); }
    __syncthreads();
}

__device__ __forceinline__ void phase_f(Frame& F) {
    const float* mod = (const float*)(F.ws + WS_MOD);
    const LAS int* tb = (const LAS int*)(F.lds + TBL_OFF);
    const int v = F.vcu, b = v >> 7, lane = F.lane, r0 = 64 * v + 8 * F.wave;
    const int* pair = (const int*)(F.ws + WS_PAIR); const float* pw = (const float*)(F.ws + WS_PAIR + 512 * 1024);
    const bf16_t* Y = (const bf16_t*)(F.ws + WS_Y);
    f32x4 g2[4];
#pragma unroll
    for (int j = 0; j < 4; ++j) g2[j] = *(const f32x4*)(mod + b * 6144 + 5 * D + 4 * lane + 256 * j);
    int slotv; float wv;
    { const int l = lane & 31; const int pr = pair[r0 * 4 + l]; wv = pw[r0 * 4 + l]; const int e = pr >> 20, idx = pr & 0xfffff; slotv = tb[32 + e] * 256 + idx; }
    u32x2 yv[2][4][4]; f32x4 ov[2][4];
#define F_ISSUE(i, s) do { _Pragma("unroll") for (int k = 0; k < 4; ++k) { const int sl = __builtin_amdgcn_readlane(slotv, 4 * (i) + k); const GAS u32x2* yr = (const GAS u32x2*)(Y + (size_t)sl * D) + lane; \
            _Pragma("unroll") for (int j = 0; j < 4; ++j) yv[s][k][j] = yr[64 * j]; } \
        { const GAS f32x4* orow = (const GAS f32x4*)(F.out + (size_t)(r0 + (i)) * D) + lane; _Pragma("unroll") for (int j = 0; j < 4; ++j) ov[s][j] = orow[64 * j]; } } while (0)
    F_ISSUE(0, 0);
#pragma unroll
    for (int i = 0; i < 8; ++i) { const int s = i & 1;
        if (i + 1 < 8) F_ISSUE(i + 1, s ^ 1);
        __builtin_amdgcn_sched_barrier(0);
        f32x4 acc[4];
#pragma unroll
        for (int j = 0; j < 4; ++j) acc[j] = (f32x4){0.f, 0.f, 0.f, 0.f};
#pragma unroll
        for (int k = 0; k < 4; ++k) { const float wk = __builtin_bit_cast(float, __builtin_amdgcn_readlane(__builtin_bit_cast(int, wv), 4 * i + k));
#pragma unroll
            for (int j = 0; j < 4; ++j) { const u32x2 y = yv[s][k][j]; acc[j] += wk * (f32x4){bflo(y.x), bfhi(y.x), bflo(y.y), bfhi(y.y)}; } }
        GAS f32x4* orow = (GAS f32x4*)(F.out + (size_t)(r0 + i) * D) + lane;
#pragma unroll
        for (int j = 0; j < 4; ++j) orow[64 * j] = ov[s][j] + g2[j] * acc[j];
        __builtin_amdgcn_sched_barrier(0); }
#undef F_ISSUE
}

struct Args { const float* in[24]; float* out; unsigned char* ws; int ph_lo, ph_hi; };
__global__ void __launch_bounds__(NWAVES * 64, 2) mk_fwd(Args args) {
    extern __shared__ __attribute__((aligned(16))) unsigned char lds[];
    Frame F;
    F.lds = (LAS unsigned char*)lds;
    F.MISC = (volatile LAS unsigned*)(F.lds + MISC_OFF);
    F.tid = threadIdx.x; F.lane = F.tid & 63; F.wave = __builtin_amdgcn_readfirstlane(F.tid >> 6);
    F.G = gridDim.x; { const int bx = blockIdx.x; F.vcu = (F.G % 8 == 0) ? (bx % 8) * (F.G / 8) + bx / 8 : bx; }
    F.ws = args.ws; F.ctl = (gu32*)(args.ws + WS_CTL); F.out = args.out;
    F.x = args.in[0]; F.c = args.in[1]; F.w_ada = args.in[2]; F.b_ada = args.in[3]; F.norm1_w = args.in[4]; F.w_in = args.in[5]; F.q_norm_w = args.in[6]; F.k_norm_w = args.in[7];
    F.lq1 = args.in[8]; F.lk1 = args.in[9]; F.lq2 = args.in[10]; F.lk2 = args.in[11]; F.subln_w = args.in[12]; F.w_attn_o = args.in[13]; F.conv_w = args.in[14]; F.w_conv_o = args.in[15];
    F.w_out = args.in[16]; F.norm2_w = args.in[17]; F.w_router = args.in[18]; F.b_router = args.in[19]; F.w_gate_up = args.in[20]; F.b_gate_up = args.in[21]; F.w_down = args.in[22]; F.b_down = args.in[23];
    for (int u = F.tid; u < (LDS_BYTES - MISC_OFF) / 4; u += NWAVES * 64) ((LAS unsigned*)(F.lds + MISC_OFF))[u] = 0u;
    __syncthreads();
    XcdBarrier bar; bar.bar = (unsigned*)(F.ctl + CW_BAR); bar.x = 0; bar.st = nullptr;
    if (!MK_PER_PHASE) bar = xcd_barrier_post((unsigned*)(F.ctl + CW_BAR), F.MISC + 8);
    if (!MK_PER_PHASE && threadIdx.x == 0) atomicOr((unsigned*)(F.ctl + CW_BAR) + XB_XMAP(blockIdx.x & 7), 1u << bar.x);
    bar.wave = F.wave;
#define GRID_BAR() do { if (!MK_PER_PHASE) xcd_barrier(bar); } while (0)
    bool xloc = false;
#define GRID_BAR_L() do { if (!MK_PER_PHASE) xcd_barrier(bar, xloc); } while (0)
    const int lo = args.ph_lo, hi = args.ph_hi;
#define IN(k) ((lo <= (k) && (k) < hi) && (F.lane = lane_opaque(), F.tid = F.wave * 64 + F.lane, true))
#define BOTH(k) (IN(k) && IN((k) + 1))
    bf16_t* PROJ = (bf16_t*)(F.ws + WS_PROJ); bf16_t* XN = (bf16_t*)(F.ws + WS_XN); bf16_t* MM = (bf16_t*)(F.ws + WS_MM);
    bf16_t* ACT = (bf16_t*)(F.ws + WS_ACT); bf16_t* YB = (bf16_t*)(F.ws + WS_Y);

    if (IN(0)) { phase_p0(F); if (BOTH(0)) { GRID_BAR();
        if (!MK_PER_PHASE && F.G == 256) { unsigned okm = 1u, seen = 0u;
#pragma unroll
            for (int k = 0; k < 8; ++k) { const unsigned w = __hip_atomic_load((unsigned*)(F.ctl + CW_BAR) + XB_XMAP(k), __ATOMIC_RELAXED, __HIP_MEMORY_SCOPE_AGENT);
                okm &= (__builtin_popcount(w) == 1 && (seen & w) == 0u) ? 1u : 0u; seen |= w; }
            xloc = __builtin_amdgcn_readfirstlane((int)okm) != 0; } } }
    if (IN(1)) { phase_p1(F); if (BOTH(1)) GRID_BAR_L(); }
    if (IN(2)) {
        {   pg8::Gemm g{(const bf16_t*)(F.ws + WS_XN8), (const bf16_t*)(F.ws + WS_WIN + 8 * MiB), D / 2, D / 2, 0}; InProjOrder S; S.so.init(M, 5120 + 1024 * CONV_FP8_PLANES, F.G, (int)blockIdx.x);
            pg8::EpiInProj E{pg8::EpiStore{PROJ, 0, nullptr, 0, 12 + 4 * CONV_FP8_PLANES, 0, C_GA}, F.q_norm_w, F.k_norm_w, (const f32x2*)(F.ws + WS_ROPE), F.ws + WS_Q8, F.ws + WS_KT, (unsigned*)(F.ctl + CW_KMAX), F.ws + WS_VT};
            pg8::gemm_phase<pg8::EpiInProj, InProjOrder, true, true>(F.lds, g, S, E, F.wave); }
        {   pg8::Gemm g{XN, (const bf16_t*)(F.ws + WS_WIN), D, D, 0}; pg8::StaticOrder S; S.init(M, 3072 - 1024 * CONV_FP8_PLANES, F.G, (int)blockIdx.x);
            pg8::EpiStore E{PROJ, 0, nullptr, 0, 1 << 30, C_CB + 1024 * CONV_FP8_PLANES, 0};
            pg8::gemm_phase<pg8::EpiStore, pg8::StaticOrder, true, false>(F.lds, g, S, E, F.wave); }
        if (BOTH(2)) GRID_BAR();
    }
    if (IN(3)) { phase_l1(F); }
    if (IN(4)) {
        {
            float lam;
            { const float a = F.lq1[F.lane] * F.lk1[F.lane], c2 = F.lq2[F.lane] * F.lk2[F.lane];
              lam = __expf(wave_sum(a)) - __expf(wave_sum(c2)) + LAMBDA_INIT; }
            const attn::BgCtx bgc{F.w_gate_up, F.w_down, F.ws + WS_WGU, F.ws + WS_WD};
            for (int i = 0; i < 4; ++i) { const int cls = F.vcu >> 5, j = F.vcu & 31, bh = (cls >> 2) * 8 + 2 * i + (j >> 4), qb = (cls & 3) * 16 + (j & 15);
                bool fastw;
                { const int gi = bh * 2 + (F.wave >> 2); const float q2 = __uint_as_float(__hip_atomic_load(F.ctl + CW_KMAX + gi, RLX_AGENT)), k2 = __uint_as_float(__hip_atomic_load(F.ctl + CW_KMAX + 32 + gi, RLX_AGENT));
                  fastw = __builtin_amdgcn_readfirstlane((sqrtf(q2 * k2) * 1.02f + 1e-3f < 15.0f) ? 1 : 0) != 0; }
                if (F.G == 256) { if (fastw) attn::attn_unit<8, true>(bh >> 3, bh & 7, qb, PROJ, (const bf16_t*)(F.ws + WS_KT), (const bf16_t*)(F.ws + WS_VT), F.ws + WS_Q8, (bf16_t*)(F.ws + WS_ON), (char*)lds, lam, F.subln_w, bgc, (i * 15 * 8) * 256 + F.vcu, 256, (const unsigned*)(F.ctl + CW_KMAX), F.wave);
                                  else attn::attn_unit<8, false>(bh >> 3, bh & 7, qb, PROJ, (const bf16_t*)(F.ws + WS_KT), (const bf16_t*)(F.ws + WS_VT), F.ws + WS_Q8, (bf16_t*)(F.ws + WS_ON), (char*)lds, lam, F.subln_w, bgc, (i * 15 * 8) * 256 + F.vcu, 256, (const unsigned*)(F.ctl + CW_KMAX), F.wave); } }
        }
        if (BOTH(4)) GRID_BAR_L();
    }
    if (IN(5)) {
        pg8::Gemm g{(const bf16_t*)(F.ws + WS_Z), (const bf16_t*)(F.ws + WS_WAO), D, D, (size_t)D * D}; ChainOrder S; S.so.init(M, D, F.G, (int)blockIdx.x);
        pg8::EpiGateChain E{MM, PROJ + PL(C_GA), PROJ + PL(C_GC), D};
        pg8::gemm_phase<pg8::EpiGateChain, ChainOrder, false>(F.lds, g, S, E, F.wave);
        if (BOTH(5)) GRID_BAR_L();
    }
    if (IN(6)) {
        pg8::Gemm g{MM, (const bf16_t*)(F.ws + WS_WOUT), D, D, 0}; pg8::StaticOrder S; S.init(M, D, F.G, (int)blockIdx.x);
        pg8::EpiResid E{F.x, F.out, (const float*)(F.ws + WS_MOD) + 2 * D};
        pg8::gemm_phase<pg8::EpiResid, pg8::StaticOrder, false>(F.lds, g, S, E, F.wave);
        if (BOTH(6)) GRID_BAR_L();
    }
    if (IN(7)) { phase_r1(F); if (BOTH(7)) GRID_BAR(); }
    if (IN(8)) {
        moe_tables(F);
        const LAS int* tb = (const LAS int*)(F.lds + TBL_OFF);
        pg8::Gemm g{XN, (const bf16_t*)(F.ws + WS_WGU), D / 2, D / 2, (size_t)2 * DFF * D / 2};
        MoeOrder S{tb[65] * 8, 8, (int)blockIdx.x, tb, (const int*)(F.ws + WS_LIST), true};
        pg8::EpiSwiglu E{(unsigned char*)ACT, F.b_gate_up};
        for (int rep = 0; rep < PROBE_REP_MOE; ++rep) pg8::gemm_phase<pg8::EpiSwiglu, MoeOrder, true, true>(F.lds, g, S, E, F.wave);
        if (BOTH(8)) GRID_BAR_L();
    }
    if (IN(9)) {
        moe_tables(F);
        const LAS int* tb = (const LAS int*)(F.lds + TBL_OFF);
        pg8::Gemm g{ACT, (const bf16_t*)(F.ws + WS_WD), DFF / 2, DFF / 2, (size_t)D * DFF / 2};
        MoeOrder S{tb[65] * 4, 4, (int)blockIdx.x, tb, nullptr, false};
        pg8::EpiStore E{YB, D, F.b_down, D, 1 << 30, 0, 0};
        for (int rep = 0; rep < PROBE_REP_MOE; ++rep) pg8::gemm_phase<pg8::EpiStore, MoeOrder, true, true>(F.lds, g, S, E, F.wave);
        if (BOTH(9)) GRID_BAR();
    }
    if (IN(10)) { moe_tables(F); phase_f(F); }
#undef IN
#undef BOTH
}

extern "C" void kernel_launch(void* const* d_in, const int* in_sizes, int n_in, void* d_out, int out_size, void* d_ws, size_t ws_size, hipStream_t stream) {
    static int grid = 0;
    if (grid == 0) {
        if (n_in != 24 || in_sizes[0] != M * D || out_size != M * D || ws_size < WS_END) { fprintf(stderr, "kernel_launch: unexpected shapes (n_in %d, in0 %d, out %d, ws %zu); nothing launched\n", n_in, n_in > 0 ? in_sizes[0] : -1, out_size, ws_size); grid = -1; return; }
        int dev = 0, cus = 0, per_cu = 0;
        if (hipGetDevice(&dev) != hipSuccess || hipDeviceGetAttribute(&cus, hipDeviceAttributeMultiprocessorCount, dev) != hipSuccess) { grid = -1; return; }
        if (hipFuncSetAttribute((const void*)mk_fwd, hipFuncAttributeMaxDynamicSharedMemorySize, LDS_BYTES) != hipSuccess) { fprintf(stderr, "kernel_launch: hipFuncSetAttribute failed\n"); grid = -1; return; }
        if (hipOccupancyMaxActiveBlocksPerMultiprocessor(&per_cu, (const void*)mk_fwd, NWAVES * 64, LDS_BYTES) != hipSuccess || per_cu < 1)
            fprintf(stderr, "kernel_launch: occupancy query reports %d workgroups per CU\n", per_cu);
        (void)hipGetLastError();
        grid = cus;
        if (grid != 256) fprintf(stderr, "kernel_launch: %d CUs; this kernel is built for 256\n", grid);
    }
    if (grid < 0) return;
    if (hipMemsetAsync((char*)d_ws + WS_CTL, 0, CTL_ZERO_BYTES, stream) != hipSuccess) { fprintf(stderr, "kernel_launch: memset failed\n"); return; }
    Args a{};
    for (int i = 0; i < 24; ++i) a.in[i] = (const float*)d_in[i];
    a.out = (float*)d_out; a.ws = (unsigned char*)d_ws;
#if MK_PER_PHASE
    for (int p = 0; p < N_PHASES; ++p) { a.ph_lo = p; a.ph_hi = p + 1; hipLaunchKernelGGL(mk_fwd, dim3(grid), dim3(NWAVES * 64), LDS_BYTES, stream, a); }
#else
    a.ph_lo = 0; a.ph_hi = N_PHASES; hipLaunchKernelGGL(mk_fwd, dim3(grid), dim3(NWAVES * 64), LDS_BYTES, stream, a);
#endif
    const hipError_t le = hipPeekAtLastError();
    if (le != hipSuccess) fprintf(stderr, "kernel_launch: launch failed: %s\n", hipGetErrorName(le));
}
```
